# Optimizing an MI355X kernel written in HIP

```python
import jax, jax.numpy as jnp
import numpy as np

D_MODEL = 1024
BATCH = 8
SEQ = 4096
DEPTH = 4

HEAD_DIM = 64
BRANCH_WIDTH = D_MODEL
A_Q_HEADS = BRANCH_WIDTH // HEAD_DIM
A_KV_HEADS = 2
A_WINDOW = 128
B_Q_HEADS = BRANCH_WIDTH // HEAD_DIM
B_KV_HEADS = 4
B_PAIRS = ((128, 1), (512, 4), (2048, 16))
N_GROUPS = len(B_PAIRS)
BLOCK = 128
ROT_DIM = HEAD_DIM // 4
ROPE_THETA = 500000.0
EPS = 1e-6
N_MIXERS = 2
N_A = (DEPTH + 1) // 2
N_B = DEPTH // 2
A_COLS = (A_Q_HEADS + 2 * A_KV_HEADS) * HEAD_DIM + BRANCH_WIDTH
B_GROUP_COLS = (B_Q_HEADS + 2 * B_KV_HEADS) * HEAD_DIM
B_COLS = N_GROUPS * B_GROUP_COLS + BRANCH_WIDTH
SCALE = HEAD_DIM ** -0.5

kernel_name = "hybrid_swa_sink_dilated_gated_trunk"


def rmsnorm(x, g):
    xf = x.astype(jnp.float32)
    y = xf * jax.lax.rsqrt(jnp.mean(xf * xf, axis=-1, keepdims=True) + EPS)
    return (y * g.astype(jnp.float32)).astype(x.dtype)


def rope_tables(seq):
    pos = jnp.arange(seq, dtype=jnp.float32)
    inv = ROPE_THETA ** (-jnp.arange(0, ROT_DIM, 2, dtype=jnp.float32) / ROT_DIM)
    ang = pos[:, None] * inv[None, :]
    return jnp.cos(ang), jnp.sin(ang)


def partial_rope(t, cos, sin):
    tf = t.astype(jnp.float32)
    half = ROT_DIM // 2
    t1, t2, rest = tf[..., :half], tf[..., half:ROT_DIM], tf[..., ROT_DIM:]
    c = cos[None, :, None, :]
    s = sin[None, :, None, :]
    out = jnp.concatenate([t1 * c - t2 * s, t2 * c + t1 * s, rest], axis=-1)
    return out.astype(t.dtype)


def banded_attention(q, k, v, max_dist, sink=None):
    n, L, hq, d = q.shape
    hkv = k.shape[2]
    rep = hq // hkv
    nb = -(-L // BLOCK)
    lp = nb * BLOCK
    pad = ((0, 0), (0, lp - L), (0, 0), (0, 0))
    q, k, v = jnp.pad(q, pad), jnp.pad(k, pad), jnp.pad(v, pad)
    qb = q.reshape(n, nb, BLOCK, hkv, rep, d)

    def with_prev(t):
        tb = t.reshape(n, nb, BLOCK, hkv, d)
        prev = jnp.pad(tb, ((0, 0), (1, 0), (0, 0), (0, 0), (0, 0)))[:, :-1]
        return jnp.concatenate([prev, tb], axis=2)

    kk, vv = with_prev(k), with_prev(v)
    s = jnp.einsum('nbqgrd,nbkgd->nbgrqk', qb, kk,
                   preferred_element_type=jnp.float32) * SCALE
    i = jnp.arange(BLOCK)[:, None]
    j = jnp.arange(2 * BLOCK)[None, :]
    dist = BLOCK + i - j
    blk = jnp.arange(nb)[:, None, None]
    valid = (dist >= 0) & (dist <= max_dist) & ((blk > 0) | (j >= BLOCK))
    s = jnp.where(valid[None, :, None, None], s, -jnp.inf)
    m = jnp.max(s, axis=-1)
    if sink is not None:
        sk = sink.astype(jnp.float32).reshape(hkv, rep)[None, None, :, :, None]
        m = jnp.maximum(m, sk)
    p = jnp.exp(s - m[..., None])
    l = jnp.sum(p, axis=-1)
    if sink is not None:
        l = l + jnp.exp(sk - m)
    o = jnp.einsum('nbgrqk,nbkgd->nbgrqd', p, vv.astype(jnp.float32)) / l[..., None]
    o = o.transpose(0, 1, 4, 2, 3, 5).reshape(n, lp, hq, d)[:, :L]
    lse = (m + jnp.log(l)).transpose(0, 1, 4, 2, 3).reshape(n, lp, hq)[:, :L]
    return o.astype(q.dtype), lse


def dilated_group(q, k, v, window, dilation):
    b, s, hq, d = q.shape
    sub = s // dilation

    def fold(t):
        return t.reshape(b, sub, dilation, t.shape[2], d).swapaxes(1, 2).reshape(b * dilation, sub, t.shape[2], d)

    o, lse = banded_attention(fold(q), fold(k), fold(v), window // dilation)
    o = o.reshape(b, dilation, sub, hq, d).swapaxes(1, 2).reshape(b, s, hq, d)
    lse = lse.reshape(b, dilation, sub, hq).swapaxes(1, 2).reshape(b, s, hq)
    return o, lse


def mixer_a(h, w_in, q_gain, k_gain, sinks, cos, sin):
    b, s, _ = h.shape
    z = h @ w_in
    nq, nk = A_Q_HEADS * HEAD_DIM, A_KV_HEADS * HEAD_DIM
    q, k, v, gate = jnp.split(z, [nq, nq + nk, nq + 2 * nk], axis=-1)
    q = partial_rope(rmsnorm(q.reshape(b, s, A_Q_HEADS, HEAD_DIM), q_gain), cos, sin)
    k = partial_rope(rmsnorm(k.reshape(b, s, A_KV_HEADS, HEAD_DIM), k_gain), cos, sin)
    v = v.reshape(b, s, A_KV_HEADS, HEAD_DIM)
    o, _ = banded_attention(q, k, v, A_WINDOW - 1, sink=sinks)
    return o.reshape(b, s, BRANCH_WIDTH) * jax.nn.silu(gate)


def mixer_b(h, w_in, q_gain, k_gain, cos, sin):
    b, s, _ = h.shape
    z = h @ w_in
    heads = z[..., :N_GROUPS * B_GROUP_COLS].reshape(b, s, N_GROUPS, B_GROUP_COLS)
    gate = z[..., N_GROUPS * B_GROUP_COLS:]
    nq, nk = B_Q_HEADS * HEAD_DIM, B_KV_HEADS * HEAD_DIM
    outs, lses = [], []
    for g, (window, dilation) in enumerate(B_PAIRS):
        q, k, v = jnp.split(heads[:, :, g], [nq, nq + nk], axis=-1)
        q = partial_rope(rmsnorm(q.reshape(b, s, B_Q_HEADS, HEAD_DIM), q_gain[g]), cos, sin)
        k = partial_rope(rmsnorm(k.reshape(b, s, B_KV_HEADS, HEAD_DIM), k_gain[g]), cos, sin)
        v = v.reshape(b, s, B_KV_HEADS, HEAD_DIM)
        o, lse = dilated_group(q, k, v, window, dilation)
        outs.append(o)
        lses.append(lse)
    wts = jax.nn.softmax(jnp.stack(lses), axis=0)
    o = jnp.einsum('gbsh,gbshd->bshd', wts, jnp.stack(outs).astype(jnp.float32))
    return o.reshape(b, s, BRANCH_WIDTH).astype(h.dtype) * jax.nn.silu(gate)


def setup_inputs(seed: int = 0) -> dict:
    key = jax.random.key(seed)
    ks = jax.random.split(key, 12)
    f32 = jnp.float32
    x = jax.random.normal(ks[0], (BATCH, SEQ, D_MODEL), f32)
    norm_a = 1.0 + 0.02 * jax.random.normal(ks[1], (N_A, D_MODEL), f32)
    w_in_a = jax.random.normal(ks[2], (N_A, D_MODEL, A_COLS), f32) * D_MODEL ** -0.5
    q_gain_a = 1.0 + 0.02 * jax.random.normal(ks[3], (N_A, HEAD_DIM), f32)
    k_gain_a = 1.0 + 0.02 * jax.random.normal(ks[4], (N_A, HEAD_DIM), f32)
    sinks_a = jax.random.normal(ks[5], (N_A, A_Q_HEADS), f32)
    w_out_a = jax.random.normal(ks[6], (N_A, BRANCH_WIDTH, D_MODEL), f32) * BRANCH_WIDTH ** -0.5
    norm_b = 1.0 + 0.02 * jax.random.normal(ks[7], (N_B, D_MODEL), f32)
    w_in_b = jax.random.normal(ks[8], (N_B, D_MODEL, B_COLS), f32) * D_MODEL ** -0.5
    q_gain_b = 1.0 + 0.02 * jax.random.normal(ks[9], (N_B, N_GROUPS, HEAD_DIM), f32)
    k_gain_b = 1.0 + 0.02 * jax.random.normal(ks[10], (N_B, N_GROUPS, HEAD_DIM), f32)
    w_out_b = jax.random.normal(ks[11], (N_B, BRANCH_WIDTH, D_MODEL), f32) * BRANCH_WIDTH ** -0.5
    return {"x": x, "norm_a": norm_a, "w_in_a": w_in_a, "q_gain_a": q_gain_a,
            "k_gain_a": k_gain_a, "sinks_a": sinks_a, "w_out_a": w_out_a,
            "norm_b": norm_b, "w_in_b": w_in_b, "q_gain_b": q_gain_b,
            "k_gain_b": k_gain_b, "w_out_b": w_out_b}


def reference(x, norm_a, w_in_a, q_gain_a, k_gain_a, sinks_a, w_out_a,
              norm_b, w_in_b, q_gain_b, k_gain_b, w_out_b):
    cos, sin = rope_tables(x.shape[1])
    for layer in range(DEPTH):
        idx = layer // N_MIXERS
        if layer % N_MIXERS == 0:
            h = rmsnorm(x, norm_a[idx])
            y = mixer_a(h, w_in_a[idx], q_gain_a[idx], k_gain_a[idx], sinks_a[idx], cos, sin)
            x = x + y @ w_out_a[idx]
        else:
            h = rmsnorm(x, norm_b[idx])
            y = mixer_b(h, w_in_b[idx], q_gain_b[idx], k_gain_b[idx], cos, sin)
            x = x + y @ w_out_b[idx]
    return x
```

```cpp
#include <hip/hip_runtime.h>
#include <hip/hip_cooperative_groups.h>
#include <cstdio>
#include <cstdint>
namespace cg = cooperative_groups;
namespace pg8 {
#define PG8_LAS __attribute__((address_space(3)))
typedef unsigned short bf16_t;
typedef short bf16x8 __attribute__((ext_vector_type(8)));
typedef float f32x4 __attribute__((ext_vector_type(4)));
typedef unsigned u32x4 __attribute__((ext_vector_type(4)));
constexpr int BM = 256, BK = 64, HALF = 128, HTB = HALF * BK * 2  , STAGE_BYTES = 8 * HTB, NXCD = 8, WGM = 4;

__host__ __device__ __forceinline__ int lds_byte(int r, int c) { const int st = (r >> 4) * 2 + (c >> 5), rr = r & 15, cc = c & 31, ob = rr * 64 + cc * 2; return st * 1024 + (ob ^ (((ob >> 9) & 1) << 5)); }
__host__ __device__ __forceinline__ void stage_rc(int b, int& R, int& C) { const int st = b / 1024, sb = b % 1024, swz = sb ^ (((sb >> 9) & 1) << 5); R = (st >> 1) * 16 + swz / 64; C = (st & 1) * 32 + (swz % 64) / 2; }
__host__ __device__ __forceinline__ int perm32(int rho) { const int n = rho >> 4, i = rho & 15; return 8 * (i >> 2) + 4 * n + (i & 3); }

struct Unit { int pm, pn; };
struct Gemm { const bf16_t* A; const bf16_t* Bt; int M, N, K; };

struct StaticOrder {
    int nM, nN, nwg, G, c;
    __host__ __device__ void init(int M, int N, int G_, int c_) { nM = M / BM; nN = N / BM; nwg = nM * nN; G = G_; c = c_; }
    __host__ __device__ bool next(int i, Unit& u) const {
        const long L = (long)i * G + c; if (L >= nwg) return false;
        int wgid = (int)L; { const int q = nwg / NXCD, r = nwg % NXCD, xcd = wgid % NXCD, off = wgid / NXCD; wgid = (xcd < r ? xcd * (q + 1) : r * (q + 1) + (xcd - r) * q) + off; }
        const int nig = WGM * nN, gid = wgid / nig, fm = gid * WGM, gsz = (nM - fm) < WGM ? (nM - fm) : WGM;
        u.pm = fm + ((wgid % nig) % gsz); u.pn = (wgid % nig) / gsz; return true;
    }
    __device__ __forceinline__ void a_ready(const Unit&) const {}
    __device__ __forceinline__ void done(const Unit&) const {}
};

__device__ __forceinline__ unsigned cvt_pk_bf16(float lo, float hi) { unsigned r; asm volatile("v_cvt_pk_bf16_f32 %0, %1, %2" : "=v"(r) : "v"(lo), "v"(hi)); return r; }
typedef float f32x2 __attribute__((ext_vector_type(2)));
template <class Epi, class Sched, bool ALIGN_EPI = false, bool SP2 = false>
__device__ __forceinline__ void gemm_phase(PG8_LAS unsigned char* lds, const Gemm g, const Sched& S, const Epi& E) {
    int tid_ = threadIdx.x; asm volatile("" : "+v"(tid_));
    const int tid = tid_, wid = __builtin_amdgcn_readfirstlane(tid >> 6), lane = tid & 63, wr = wid >> 2, wc = wid & 3, fr = lane & 15, fq = lane >> 4;
    const int K = g.K, nt = K / BK;
    unsigned voffA[2], voffB[2];
#pragma unroll
    for (int i = 0; i < 2; ++i) { int R, C; stage_rc(tid * 16 + i * 8192, R, C); const int Rb = Epi::PERM ? ((R & ~31) + perm32(R & 31)) : R;
        voffA[i] = (unsigned)(R * K + C) * 2u; voffB[i] = (unsigned)(Rb * K + C) * 2u; }
    const size_t kstep = (size_t)(BK * 2);
    const size_t hstep = (size_t)HALF * K * 2;
    const size_t tstep = 2 * hstep;
    const unsigned ldsw = (unsigned)wid * 1024u;
    const int aoff = lds_byte(wr * 64 + fr, fq * 8), boff = lds_byte(wc * 32 + fr, fq * 8);
#define PG8_SA(b, h) (((b) * 2 + (h)) * HTB)
#define PG8_SB(b, h) ((4 + (b) * 2 + (h)) * HTB)
#define PG8_STAGE(bufoff, gbase, voff) do { _Pragma("unroll") for (int _i = 0; _i < 2; ++_i) \
        __builtin_amdgcn_global_load_lds((const unsigned*)((const char*)(gbase) + (voff)[_i]), (PG8_LAS unsigned*)(lds + (bufoff) + ldsw + _i * 8192), 16, 0, 0); } while (0)
#define PG8_LDA(dst, b, h) do { _Pragma("unroll") for (int m = 0; m < 4; ++m) _Pragma("unroll") for (int k = 0; k < 2; ++k) dst[m][k] = *(const PG8_LAS bf16x8*)(lds + PG8_SA(b, h) + aoff + m * 2048 + k * 1024); } while (0)
#define PG8_LDB(dst, b, h) do { _Pragma("unroll") for (int n = 0; n < 2; ++n) _Pragma("unroll") for (int k = 0; k < 2; ++k) dst[n][k] = *(const PG8_LAS bf16x8*)(lds + PG8_SB(b, h) + boff + n * 2048 + k * 1024); } while (0)
#define PG8_MMA(ai, bj, At, Bt) do { __builtin_amdgcn_s_setprio(1); _Pragma("unroll") for (int m = 0; m < 4; ++m) _Pragma("unroll") for (int n = 0; n < 2; ++n) _Pragma("unroll") for (int k = 0; k < 2; ++k) \
        acc[ai][bj][m][n] = __builtin_amdgcn_mfma_f32_16x16x32_bf16(Bt[n][k], At[m][k], acc[ai][bj][m][n], 0, 0, 0); __builtin_amdgcn_s_setprio(0); } while (0)
#define PG8_WAIT_V(n) asm volatile("s_waitcnt vmcnt(" #n ")" ::: "memory")
#define PG8_WAIT_L(n) asm volatile("s_waitcnt lgkmcnt(" #n ")" ::: "memory")
#define PG8_BAR __builtin_amdgcn_s_barrier()
#define PG8_SCHED __builtin_amdgcn_sched_barrier(0)
    Unit cur, nxt; int ui = 0;
    if (!S.next(0, cur)) return;
    f32x4 acc[2][2][4][2];
#pragma unroll
    for (int a = 0; a < 2; ++a)
#pragma unroll
        for (int b = 0; b < 2; ++b)
#pragma unroll
            for (int m = 0; m < 4; ++m)
#pragma unroll
                for (int n = 0; n < 2; ++n) acc[a][b][m][n] = (f32x4){0.f, 0.f, 0.f, 0.f};
    bf16x8 At[4][2], B0[2][2], B1[2][2];
    const char* cA = (const char*)g.A + (size_t)cur.pm * tstep; const char* cB = (const char*)g.Bt + (size_t)cur.pn * tstep;
    S.a_ready(cur);
    if constexpr (SP2) {
        PG8_STAGE(PG8_SB(0, 0), cB, voffB); PG8_STAGE(PG8_SB(0, 1), cB + hstep, voffB); PG8_STAGE(PG8_SA(0, 0), cA, voffA); PG8_STAGE(PG8_SA(0, 1), cA + hstep, voffA);
        if (wr == 1) PG8_BAR;
        PG8_WAIT_V(2); PG8_BAR;
        PG8_STAGE(PG8_SB(1, 0), cB + kstep, voffB); PG8_STAGE(PG8_SA(1, 0), cA + kstep, voffA); PG8_STAGE(PG8_SB(1, 1), cB + hstep + kstep, voffB);
        PG8_WAIT_V(6); PG8_BAR;
    } else {
        PG8_STAGE(PG8_SB(0, 0), cB, voffB); PG8_STAGE(PG8_SA(0, 0), cA, voffA); PG8_STAGE(PG8_SB(0, 1), cB + hstep, voffB); PG8_STAGE(PG8_SA(0, 1), cA + hstep, voffA);
        if (wr == 1) PG8_BAR;
        PG8_WAIT_V(4); PG8_BAR;
        PG8_STAGE(PG8_SB(1, 0), cB + kstep, voffB); PG8_STAGE(PG8_SA(1, 0), cA + kstep, voffA); PG8_STAGE(PG8_SB(1, 1), cB + hstep + kstep, voffB);
        PG8_WAIT_V(6); PG8_BAR;
    }
    for (;;) {
        const bool has_next = S.next(ui + 1, nxt);
        const char* nA = has_next ? (const char*)g.A + (size_t)nxt.pm * tstep : cA; const char* nB = has_next ? (const char*)g.Bt + (size_t)nxt.pn * tstep : cB;
        for (int t = 0; t < nt; t += 2) {
            const bool last = (t == nt - 2);
            const char* a1 = cA + (size_t)(t + 1) * kstep;
            const char* a2 = last ? nA : cA + (size_t)(t + 2) * kstep; const char* b2 = last ? nB : cB + (size_t)(t + 2) * kstep;
            const char* a3 = a2 + kstep; const char* b3 = b2 + kstep;
            if (last && has_next) S.a_ready(nxt);
            if constexpr (SP2) {
            PG8_LDB(B0, 0, 0); PG8_LDB(B1, 0, 1); PG8_SCHED; PG8_LDA(At, 0, 0); PG8_STAGE(PG8_SA(1, 1), a1 + hstep, voffA);
            PG8_WAIT_V(8); PG8_WAIT_L(0); PG8_BAR; PG8_MMA(0, 0, At, B0); PG8_MMA(0, 1, At, B1); PG8_BAR; PG8_SCHED;
            PG8_LDA(At, 0, 1); PG8_STAGE(PG8_SB(0, 0), b2, voffB); PG8_STAGE(PG8_SB(0, 1), b2 + hstep, voffB); PG8_STAGE(PG8_SA(0, 0), a2, voffA);
            PG8_WAIT_V(8); PG8_WAIT_L(0); PG8_BAR; PG8_MMA(1, 0, At, B0); PG8_MMA(1, 1, At, B1); PG8_BAR; PG8_SCHED;
            PG8_LDB(B0, 1, 0); PG8_LDB(B1, 1, 1); PG8_SCHED; PG8_LDA(At, 1, 0); PG8_STAGE(PG8_SA(0, 1), a2 + hstep, voffA);
            PG8_WAIT_V(8); PG8_WAIT_L(0); PG8_BAR; PG8_MMA(0, 0, At, B0); PG8_MMA(0, 1, At, B1); PG8_BAR; PG8_SCHED;
            PG8_LDA(At, 1, 1); PG8_STAGE(PG8_SB(1, 0), b3, voffB); PG8_STAGE(PG8_SB(1, 1), b3 + hstep, voffB); PG8_STAGE(PG8_SA(1, 0), a3, voffA);
            PG8_WAIT_V(8); PG8_WAIT_L(0); PG8_BAR; PG8_MMA(1, 0, At, B0); PG8_MMA(1, 1, At, B1); PG8_BAR; PG8_SCHED;
            } else {
            PG8_LDB(B0, 0, 0); PG8_SCHED; PG8_LDA(At, 0, 0); PG8_STAGE(PG8_SA(1, 1), a1 + hstep, voffA);
            PG8_WAIT_L(8); PG8_BAR; PG8_WAIT_L(0); PG8_MMA(0, 0, At, B0); PG8_BAR; PG8_SCHED;
            PG8_LDB(B1, 0, 1); PG8_STAGE(PG8_SB(0, 0), b2, voffB);
            PG8_BAR; PG8_WAIT_L(0); PG8_MMA(0, 1, At, B1); PG8_BAR;
            PG8_LDA(At, 0, 1); PG8_STAGE(PG8_SA(0, 0), a2, voffA);
            PG8_BAR; PG8_WAIT_L(0); PG8_MMA(1, 0, At, B0); PG8_BAR; PG8_SCHED;
            PG8_STAGE(PG8_SB(0, 1), b2 + hstep, voffB);
            PG8_WAIT_V(6); PG8_BAR; PG8_MMA(1, 1, At, B1); PG8_BAR;
            PG8_LDB(B0, 1, 0); PG8_SCHED; PG8_LDA(At, 1, 0); PG8_STAGE(PG8_SA(0, 1), a2 + hstep, voffA);
            PG8_WAIT_L(8); PG8_BAR; PG8_WAIT_L(0); PG8_MMA(0, 0, At, B0); PG8_BAR; PG8_SCHED;
            PG8_LDB(B1, 1, 1); PG8_STAGE(PG8_SB(1, 0), b3, voffB);
            PG8_BAR; PG8_WAIT_L(0); PG8_MMA(0, 1, At, B1); PG8_BAR;
            PG8_LDA(At, 1, 1); PG8_STAGE(PG8_SA(1, 0), a3, voffA);
            PG8_BAR; PG8_WAIT_L(0); PG8_MMA(1, 0, At, B0); PG8_BAR; PG8_SCHED;
            PG8_STAGE(PG8_SB(1, 1), b3 + hstep, voffB);
            PG8_WAIT_V(6); PG8_BAR; PG8_MMA(1, 1, At, B1); PG8_BAR;
            }
        }
        if constexpr (ALIGN_EPI) { if (wr == 0) PG8_BAR; }
        if constexpr (!Epi::AFTER_DRAIN) { E(acc, cur, wr, wc, fr, fq); S.done(cur); }
        if (!has_next) break;
#pragma unroll
        for (int a = 0; a < 2; ++a)
#pragma unroll
            for (int b = 0; b < 2; ++b)
#pragma unroll
                for (int m = 0; m < 4; ++m)
#pragma unroll
                    for (int n = 0; n < 2; ++n) acc[a][b][m][n] = (f32x4){0.f, 0.f, 0.f, 0.f};
        cur = nxt; cA = nA; cB = nB; ++ui;
        if constexpr (ALIGN_EPI) { if (wr == 1) PG8_BAR; }
    }
    PG8_WAIT_V(0);
    if constexpr (!ALIGN_EPI) { if (wr == 0) PG8_BAR; }
    PG8_BAR;
    if constexpr (Epi::AFTER_DRAIN) { E.fused(acc, cur, wr, wc, fr, fq, lds, wid, lane); S.done(cur); }
#undef PG8_SA
#undef PG8_SB
#undef PG8_STAGE
#undef PG8_LDA
#undef PG8_LDB
#undef PG8_MMA
#undef PG8_WAIT_V
#undef PG8_WAIT_L
#undef PG8_BAR
#undef PG8_SCHED
}
}

#define LAS __attribute__((address_space(3)))
typedef unsigned short bf16_t;
typedef short bf16x8 __attribute__((ext_vector_type(8)));
typedef short s16x4 __attribute__((ext_vector_type(4)));
typedef short v4i16_t __attribute__((ext_vector_type(4)));
typedef float f32x4 __attribute__((ext_vector_type(4)));
typedef float f32x2v __attribute__((ext_vector_type(2)));
typedef float f32x16 __attribute__((ext_vector_type(16)));
typedef unsigned u32x4 __attribute__((ext_vector_type(4)));
typedef unsigned u32x2 __attribute__((ext_vector_type(2)));
typedef __bf16 bf2_t __attribute__((ext_vector_type(2)));

constexpr int NTOK = 32768, DM = 1024, SEQ = 4096, NA = 2304, NB = 5632;
constexpr float EPS = 1e-6f, LOG2E = 1.4426950408889634f, QSCALE = 0.125f * 1.4426950408889634f;
constexpr size_t MiB = 1u << 20;
constexpr size_t WS_WINA = 0, WS_WINB = 10 * MiB, WS_WOUT = 32 * MiB, WS_XB = 40 * MiB, WS_ROWSQ = 104 * MiB, WS_ROPE = 105 * MiB,
                 WS_Q = 106 * MiB, WS_K = 298 * MiB, WS_V = 346 * MiB, WS_G = 394 * MiB, WS_LO8 = 458 * MiB, WS_END = 490 * MiB;
constexpr size_t WS_CTL = 105 * MiB + 512 * 1024, CTL_BYTES = 16384;
constexpr int MISC_OFF = 155584;
constexpr int LDS_BYTES = 155648;

struct Params {
    const float* x; const float* norm_a; const float* w_in_a; const float* q_gain_a; const float* k_gain_a; const float* sinks_a; const float* w_out_a;
    const float* norm_b; const float* w_in_b; const float* q_gain_b; const float* k_gain_b; const float* w_out_b;
    float* out; unsigned char* ws;
};

__device__ __forceinline__ unsigned pkbf(float lo, float hi) { f32x2v v = {lo, hi}; return __builtin_bit_cast(unsigned, __builtin_convertvector(v, bf2_t)); }
__device__ __forceinline__ float bflo(unsigned w) { return __uint_as_float(w << 16); }
__device__ __forceinline__ float bfhi(unsigned w) { return __uint_as_float(w & 0xffff0000u); }


__device__ __forceinline__ float sum_fq(float x) {
    auto a = __builtin_amdgcn_permlane16_swap(__float_as_uint(x), __float_as_uint(x), false, false);
    const float y = __uint_as_float(a[0]) + __uint_as_float(a[1]);
    auto b = __builtin_amdgcn_permlane32_swap(__float_as_uint(y), __float_as_uint(y), false, false);
    return __uint_as_float(b[0]) + __uint_as_float(b[1]);
}
struct EpiIn {
    static constexpr bool PERM = true, AFTER_DRAIN = false;
    int mixer; const float* rowsq; const float* qg; const float* kg; const float* rope; bf16_t* Q; bf16_t* Kb; bf16_t* Vb; bf16_t* G;
    __device__ __forceinline__ void operator()(const pg8::f32x4 (&acc)[2][2][4][2], const pg8::Unit& u, int wr, int wc, int fr, int fq) const {
        const int L = 256 * u.pn + 64 * wc;
        int type, head, ld; bf16_t* dst; const float* gain = nullptr;
        if (mixer == 0) {
            if (L < 1024) { type = 0; head = L >> 6; dst = Q; ld = 1024; gain = qg; }
            else if (L < 1152) { type = 1; head = (L - 1024) >> 6; dst = Kb; ld = 128; gain = kg; }
            else if (L < 1280) { type = 2; head = (L - 1152) >> 6; dst = Vb; ld = 128; }
            else { type = 3; head = (L - 1280) >> 6; dst = G; ld = 1024; }
        } else {
            if (L < 4608) { const int g = L / 1536, l = L - g * 1536;
                if (l < 1024) { type = 0; head = l >> 6; dst = Q + (size_t)g * NTOK * 1024; ld = 1024; gain = qg + 64 * g; }
                else if (l < 1280) { type = 1; head = (l - 1024) >> 6; dst = Kb + (size_t)g * NTOK * 256; ld = 256; gain = kg + 64 * g; }
                else { type = 2; head = (l - 1280) >> 6; dst = Vb + (size_t)g * NTOK * 256; ld = 256; } }
            else { type = 3; head = (L - 4608) >> 6; dst = G; ld = 1024; }
        }
        dst += head * 64 + 8 * fq;
        float rstd[2][4];
#pragma unroll
        for (int ai = 0; ai < 2; ++ai)
#pragma unroll
            for (int m = 0; m < 4; ++m) rstd[ai][m] = rowsq[u.pm * 256 + ai * 128 + wr * 64 + m * 16 + fr];
#pragma unroll
        for (int ai = 0; ai < 2; ++ai)
#pragma unroll
            for (int m = 0; m < 4; ++m) rstd[ai][m] = __builtin_amdgcn_rsqf(rstd[ai][m] * (1.0f / 1024.0f) + EPS);
        if (type <= 1) rows<0>(acc, u, wr, fr, fq, rstd, dst, ld, gain, type == 0 ? QSCALE : 1.0f);
        else if (type == 2) rows<2>(acc, u, wr, fr, fq, rstd, dst, ld, nullptr, 1.0f);
        else rows<3>(acc, u, wr, fr, fq, rstd, dst, ld, nullptr, 1.0f);
    }
    template <int TYPE  >
    __device__ __forceinline__ void rows(const pg8::f32x4 (&acc)[2][2][4][2], const pg8::Unit& u, int wr, int fr, int fq, const float (&rstd)[2][4], bf16_t* dst, int ld, const float* gain, float qs) const {
        float gn[2][2][4];
        if (TYPE == 0) {
#pragma unroll
            for (int bj = 0; bj < 2; ++bj)
#pragma unroll
                for (int n = 0; n < 2; ++n) { const int d0 = (bj == 0 && fq < 2) ? 4 * fq + 8 * n : 32 * bj + 8 * fq + 4 * n;
                    const f32x4 g4 = *(const f32x4*)(gain + d0);
#pragma unroll
                    for (int e = 0; e < 4; ++e) gn[bj][n][e] = g4[e] * qs; }
        }
#pragma unroll
        for (int ai = 0; ai < 2; ++ai)
#pragma unroll
            for (int m = 0; m < 4; ++m) {
                const int row = u.pm * 256 + ai * 128 + wr * 64 + m * 16 + fr;
                float v[2][2][4];
                if (TYPE == 0) {
                    float ss = 0.f;
#pragma unroll
                    for (int bj = 0; bj < 2; ++bj)
#pragma unroll
                        for (int n = 0; n < 2; ++n)
#pragma unroll
                            for (int e = 0; e < 4; ++e) ss += acc[ai][bj][m][n][e] * acc[ai][bj][m][n][e];
                    ss = sum_fq(ss);
                    const float r1 = rstd[ai][m], sc = r1 * __builtin_amdgcn_rsqf(r1 * r1 * ss * (1.0f / 64.0f) + EPS);
#pragma unroll
                    for (int bj = 0; bj < 2; ++bj)
#pragma unroll
                        for (int n = 0; n < 2; ++n)
#pragma unroll
                            for (int e = 0; e < 4; ++e) v[bj][n][e] = acc[ai][bj][m][n][e] * sc * gn[bj][n][e];
                    const float* rp = rope + (size_t)(row & (SEQ - 1)) * 16 + 4 * (fq & 1);
                    const f32x4 cs = *(const f32x4*)rp, sn = *(const f32x4*)(rp + 8);
#pragma unroll
                    for (int e = 0; e < 4; ++e) {
                        const float t1 = v[0][0][e], t2 = v[0][1][e];
                        const float o1 = t1 * cs[e] - t2 * sn[e], o2 = t2 * cs[e] + t1 * sn[e];
                        v[0][0][e] = fq < 2 ? o1 : t1; v[0][1][e] = fq < 2 ? o2 : t2;
                    }
                } else {
#pragma unroll
                    for (int bj = 0; bj < 2; ++bj)
#pragma unroll
                        for (int n = 0; n < 2; ++n)
#pragma unroll
                            for (int e = 0; e < 4; ++e) { const float z = acc[ai][bj][m][n][e] * rstd[ai][m]; v[bj][n][e] = TYPE == 3 ? z * __builtin_amdgcn_rcpf(1.0f + __expf(-z)) : z; }
                }
                bf16_t* rowp = dst + (size_t)row * ld;
#pragma unroll
                for (int bj = 0; bj < 2; ++bj) {
                    u32x4 w; w.x = pkbf(v[bj][0][0], v[bj][0][1]); w.y = pkbf(v[bj][0][2], v[bj][0][3]); w.z = pkbf(v[bj][1][0], v[bj][1][1]); w.w = pkbf(v[bj][1][2], v[bj][1][3]);
                    *(u32x4*)(rowp + 32 * bj) = w;
                }
            }
    }
};

struct EpiOut {
    static constexpr bool PERM = true, AFTER_DRAIN = false;
    const float* xin32; bf16_t* xb; unsigned char* lo8; float* out32; float* rowsq_next;
    __device__ __forceinline__ void operator()(const pg8::f32x4 (&acc)[2][2][4][2], const pg8::Unit& u, int wr, int wc, int fr, int fq) const {
        if (xin32) run<true, false>(acc, u, wr, wc, fr, fq); else if (out32) run<false, true>(acc, u, wr, wc, fr, fq); else run<false, false>(acc, u, wr, wc, fr, fq);
    }
    template <bool INF, bool OUTF>
    __device__ __forceinline__ void run(const pg8::f32x4 (&acc)[2][2][4][2], const pg8::Unit& u, int wr, int wc, int fr, int fq) const {
        const size_t off0 = (size_t)(u.pm * 256 + wr * 64 + fr) * DM + (u.pn * 256 + wc * 32 + 8 * fq);
        f32x4 xa[2][2][2]; u32x4 xh[2][2]; u32x2 xl[2][2];
#define EPO_LOAD(B, OFF) { _Pragma("unroll") for (int bj = 0; bj < 2; ++bj) { const size_t o2 = (OFF) + bj * 128; \
            if (INF) { xa[B][bj][0] = *(const f32x4*)(xin32 + o2); xa[B][bj][1] = *(const f32x4*)(xin32 + o2 + 4); } \
            else { xh[B][bj] = *(const u32x4*)(xb + o2); xl[B][bj] = *(const u32x2*)(lo8 + o2); } } }
        constexpr bool DB = !INF && !OUTF;
        if (DB) EPO_LOAD(0, off0)
#pragma unroll
        for (int blk = 0; blk < 8; ++blk) {
            const int ai = blk >> 2, m = blk & 3;
            if (!DB) EPO_LOAD(0, off0 + (size_t)(ai * 128 + m * 16) * DM)
            else if (blk + 1 < 8) { const int ai2 = (blk + 1) >> 2, m2 = (blk + 1) & 3; EPO_LOAD((blk + 1) & 1, off0 + (size_t)(ai2 * 128 + m2 * 16) * DM) }
            __builtin_amdgcn_sched_barrier(0);
            const int row = u.pm * 256 + ai * 128 + wr * 64 + m * 16 + fr;
            const size_t off = off0 + (size_t)(ai * 128 + m * 16) * DM;
            float ss = 0.f;
#pragma unroll
            for (int bj = 0; bj < 2; ++bj) {
                const size_t o2 = off + bj * 128;
                float r[8];
#pragma unroll
                for (int n = 0; n < 2; ++n) {
                    float x0, x1, x2, x3;
                    if (INF) { const f32x4 t = xa[0][bj][n]; x0 = t.x; x1 = t.y; x2 = t.z; x3 = t.w; }
                    else { const unsigned h01 = xh[DB ? (blk & 1) : 0][bj][2 * n], h23 = xh[DB ? (blk & 1) : 0][bj][2 * n + 1]; const int lw = (int)xl[DB ? (blk & 1) : 0][bj][n];
                        const f32x2v l01 = __builtin_amdgcn_cvt_pk_f32_bf8(lw, false), l23 = __builtin_amdgcn_cvt_pk_f32_bf8(lw, true);
                        x0 = bflo(h01) + l01.x * (1.0f / 1024.0f); x1 = bfhi(h01) + l01.y * (1.0f / 1024.0f); x2 = bflo(h23) + l23.x * (1.0f / 1024.0f); x3 = bfhi(h23) + l23.y * (1.0f / 1024.0f); }
                    const f32x4 a = acc[ai][bj][m][n];
                    r[4 * n] = x0 + a.x; r[4 * n + 1] = x1 + a.y; r[4 * n + 2] = x2 + a.z; r[4 * n + 3] = x3 + a.w;
                }
#pragma unroll
                for (int e = 0; e < 8; ++e) ss += r[e] * r[e];
                if (OUTF) { f32x4 w0 = {r[0], r[1], r[2], r[3]}, w1 = {r[4], r[5], r[6], r[7]}; *(f32x4*)(out32 + o2) = w0; *(f32x4*)(out32 + o2 + 4) = w1; }
                else {
                    u32x4 hw; u32x2 lw;
#pragma unroll
                    for (int k = 0; k < 4; ++k) hw[k] = pkbf(r[2 * k], r[2 * k + 1]);
#pragma unroll
                    for (int n = 0; n < 2; ++n) { int w = 0;
                        w = __builtin_amdgcn_cvt_pk_bf8_f32((r[4 * n] - bflo(hw[2 * n])) * 1024.0f, (r[4 * n + 1] - bfhi(hw[2 * n])) * 1024.0f, w, false);
                        w = __builtin_amdgcn_cvt_pk_bf8_f32((r[4 * n + 2] - bflo(hw[2 * n + 1])) * 1024.0f, (r[4 * n + 3] - bfhi(hw[2 * n + 1])) * 1024.0f, w, true);
                        lw[n] = (unsigned)w; }
                    *(u32x4*)(xb + o2) = hw; *(u32x2*)(lo8 + o2) = lw;
                }
            }
            if (!OUTF) { ss = sum_fq(ss); if (fq == 0) atomicAdd(rowsq_next + row, ss); }
            __builtin_amdgcn_sched_barrier(0);
        }
#undef EPO_LOAD
    }
};


typedef __attribute__((address_space(1))) unsigned gu32;
#define XB_TMO      128
#define XB_XCNT(j)  (256  + 64 * (j))
#define XB_XSUB(j)  (1280 + 64 * (j))
#define XB_XGEN(j)  (2304 + 64 * (j))
#define XB_TOP      3328
#define XB_TOPGEN   3392
#define XCD_BAR_WORDS 3456
#define XB_SPIN_CAP (1u << 18)

__device__ __forceinline__ unsigned xb_ld(unsigned* p)              { return __hip_atomic_load(p, __ATOMIC_RELAXED, __HIP_MEMORY_SCOPE_AGENT); }
__device__ __forceinline__ unsigned xb_add(unsigned* p, unsigned v) { return __hip_atomic_fetch_add(p, v, __ATOMIC_RELAXED, __HIP_MEMORY_SCOPE_AGENT); }
__device__ __forceinline__ unsigned xb_xcc_id() { return (unsigned)__builtin_amdgcn_s_getreg((3 << 11) | 20) & 0xFu; }
#define XB_SPIN(cond, bar) do { unsigned _sp = 0; while (cond) { __builtin_amdgcn_s_sleep(1); \
    if ((++_sp & 255u) == 0u) { if (xb_ld(&(bar)[XB_TMO])) break; if (_sp > XB_SPIN_CAP) { atomicAdd(&(bar)[XB_TMO], 1u); break; } } } } while (0)

struct XcdBarrier {
    unsigned* bar; unsigned x;
    volatile LAS unsigned* st;
};

__device__ __forceinline__ XcdBarrier xcd_barrier_post(unsigned* bar, volatile LAS unsigned* st) {
    XcdBarrier b; b.bar = bar; b.x = xb_xcc_id(); b.st = st;
    if (threadIdx.x == 0) (void)xb_add(&bar[XB_XCNT(b.x)], 1u);
    return b;
}
__device__ __forceinline__ void xcd_barrier_complete(unsigned* bar, unsigned x, unsigned& nloc, unsigned& nx) {
    const unsigned G = gridDim.x * gridDim.y * gridDim.z;
    unsigned sum, cnt, mine, sp = 0u;
    for (;;) {
        sum = 0u; cnt = 0u; mine = 0u;
#pragma unroll
        for (unsigned j = 0; j < 16; ++j) { const unsigned c = xb_ld(&bar[XB_XCNT(j)]); sum += c; cnt += (c > 0u) ? 1u : 0u; mine = (j == x) ? c : mine; }
        if (sum == G) break;
        __builtin_amdgcn_s_sleep(1);
        if ((++sp & 255u) == 0u) { if (xb_ld(&bar[XB_TMO])) break; if (sp > XB_SPIN_CAP) { atomicAdd(&bar[XB_TMO], 1u); break; } }
    }
    nloc = mine > 0u ? mine : 1u; nx = cnt > 0u ? cnt : 1u;
}

__device__ __forceinline__ void xcd_barrier(const XcdBarrier& b) {
    asm volatile("s_waitcnt vmcnt(0)" ::: "memory");
    __syncthreads();
    if (threadIdx.x == 0) {
        unsigned* bar = b.bar;
        __builtin_amdgcn_s_waitcnt(0);
        unsigned nloc = b.st[0], nx = b.st[1];
        if (nloc == 0u) { xcd_barrier_complete(bar, b.x, nloc, nx); b.st[0] = nloc; b.st[1] = nx; }
        const unsigned old = xb_add(&bar[XB_XSUB(b.x)], 1u);
        const unsigned gen = old / nloc;
        if (old + 1u == (gen + 1u) * nloc) {
            __builtin_amdgcn_fence(__ATOMIC_RELEASE, "agent");
            asm volatile("s_waitcnt vmcnt(0)" ::: "memory");
            const unsigned og = xb_add(&bar[XB_TOP], 1u);
            const unsigned tg = og / nx;
            if (og + 1u == (tg + 1u) * nx) xb_add(&bar[XB_TOPGEN], 1u);
            else XB_SPIN(xb_ld(&bar[XB_TOPGEN]) == tg, bar);
            __builtin_amdgcn_fence(__ATOMIC_ACQUIRE, "agent");
            xb_add(&bar[XB_XGEN(b.x)], 1u);
            asm volatile("s_waitcnt vmcnt(0)" ::: "memory");
        } else {
            XB_SPIN(xb_ld(&bar[XB_XGEN(b.x)]) == gen, bar);
            __builtin_amdgcn_fence(__ATOMIC_ACQUIRE, "agent");
            asm volatile("s_waitcnt vmcnt(0)" ::: "memory");
        }
    }
    __syncthreads();
}

__device__ __forceinline__ float wave_sum(float v) {
#pragma unroll
    for (int o = 1; o < 64; o <<= 1) v += __shfl_xor(v, o);
    return v;
}
__device__ __forceinline__ void p0_transpose_item(const float* W, int K, int N, bf16_t* WT, const float* gain, bool permute, LAS float* scr, int item, int lane) {
    const int nblk = N / 32, kb = item / nblk, nb = item % nblk, k0 = 64 * kb, n0 = 32 * nb;
    int prow0 = n0; bool qkperm = false;
    if (permute) { const int pn = n0 >> 8, wc = (n0 >> 6) & 3, bj = (n0 >> 5) & 1; prow0 = 256 * pn + 128 * bj + 32 * wc;
        const bool isqk = (N == NA) ? (n0 < 1152) : (n0 < 4608 && (n0 % 1536) < 1280);
        qkperm = isqk && bj == 0; }
#pragma unroll
    for (int i = 0; i < 32; ++i) { const int kk = 2 * i + (lane >> 5); const float gk = gain ? gain[k0 + kk] : 1.0f; scr[kk * 33 + (lane & 31)] = W[(size_t)(k0 + kk) * N + n0 + (lane & 31)] * gk; }
    asm volatile("s_waitcnt lgkmcnt(0)" ::: "memory");
    const int c = lane & 7;
#pragma unroll
    for (int j = 0; j < 4; ++j) { const int n = (lane >> 3) + 8 * j; const int nsrc = (qkperm && n < 16) ? 4 * (n >> 3) + 8 * ((n >> 2) & 1) + (n & 3) : n; const LAS float* s = scr + (8 * c) * 33 + nsrc;
        u32x4 o; o.x = pkbf(s[0 * 33], s[1 * 33]); o.y = pkbf(s[2 * 33], s[3 * 33]); o.z = pkbf(s[4 * 33], s[5 * 33]); o.w = pkbf(s[6 * 33], s[7 * 33]);
        *(u32x4*)(WT + (size_t)(prow0 + n) * K + k0 + 8 * c) = o; }
    asm volatile("s_waitcnt lgkmcnt(0)" ::: "memory");
}

template <int PART>
__device__ __forceinline__ void prologue(const Params& p, LAS unsigned char* lds) {
    int tid_ = threadIdx.x; asm volatile("" : "+v"(tid_));
    const int tid = tid_, lane = tid & 63, wave = __builtin_amdgcn_readfirstlane(tid >> 6);
    LAS float* scr = (LAS float*)(lds + wave * 8704);
    const int G = gridDim.x, half = (PART == 1 && G == 256) ? 128 : 0;
    if (PART == 1 && (int)blockIdx.x < half) return;
    const int gw = ((int)blockIdx.x - half) * 8 + wave, NGW = (G - half) * 8;
    bf16_t* WinA = (bf16_t*)(p.ws + WS_WINA); bf16_t* WinB = (bf16_t*)(p.ws + WS_WINB); bf16_t* Wout = (bf16_t*)(p.ws + WS_WOUT);
    constexpr int I_A = 16 * (NA / 32), I_B = 16 * (NB / 32), I_O = 16 * (DM / 32);
    constexpr int NITEMS = 2 * I_A + 2 * I_B + 4 * I_O;
    constexpr int IT_LO = 0, IT_HI = NITEMS;
    bf16_t* xb = (bf16_t*)(p.ws + WS_XB); float* rowsq = (float*)(p.ws + WS_ROWSQ);
#pragma unroll 1
    for (int step = 0; step < 2; ++step) {
    if (((step ^ wave) & 1) == 0) {
    for (int it = IT_LO + gw; it < IT_HI; it += NGW) {
        int r = it;
        if (r < 2 * I_A) { const int i = r / I_A; r -= i * I_A; p0_transpose_item(p.w_in_a + (size_t)i * DM * NA, DM, NA, WinA + (size_t)i * NA * DM, p.norm_a + i * DM, true, scr, r, lane); continue; } r -= 2 * I_A;
        if (r < 2 * I_B) { const int i = r / I_B; r -= i * I_B; p0_transpose_item(p.w_in_b + (size_t)i * DM * NB, DM, NB, WinB + (size_t)i * NB * DM, p.norm_b + i * DM, true, scr, r, lane); continue; } r -= 2 * I_B;
        { const int layer = r / I_O; r -= layer * I_O; const float* W = (layer & 1) ? p.w_out_b + (size_t)(layer >> 1) * DM * DM : p.w_out_a + (size_t)(layer >> 1) * DM * DM;
          p0_transpose_item(W, DM, DM, Wout + (size_t)layer * DM * DM, nullptr, false, scr, r, lane); }
    }
    } else {
    for (int m0 = gw; m0 < NTOK; m0 += 4 * NGW) {
        f32x4 v[4][4];
#pragma unroll
        for (int q = 0; q < 4; ++q) { const int m = m0 + q * NGW; if (m < NTOK) { const f32x4* xr = (const f32x4*)(p.x + (size_t)m * DM) + lane;
#pragma unroll
            for (int j = 0; j < 4; ++j) v[q][j] = xr[64 * j]; } }
#pragma unroll
        for (int q = 0; q < 4; ++q) { const int m = m0 + q * NGW; if (m < NTOK) { float s = 0.f;
#pragma unroll
            for (int j = 0; j < 4; ++j) s += (v[q][j].x * v[q][j].x + v[q][j].y * v[q][j].y) + (v[q][j].z * v[q][j].z + v[q][j].w * v[q][j].w);
            s = wave_sum(s);
            u32x2* o8 = (u32x2*)(xb + (size_t)m * DM) + lane;
#pragma unroll
            for (int j = 0; j < 4; ++j) { u32x2 w; w.x = pkbf(v[q][j].x, v[q][j].y); w.y = pkbf(v[q][j].z, v[q][j].w); o8[64 * j] = w; }
            if (lane == 0) rowsq[m] = s; } }
    }
    }
    }
    const int gt = blockIdx.x * 512 + tid, NGT = gridDim.x * 512;
    for (int i = gt; i < 3 * NTOK; i += NGT) rowsq[NTOK + i] = 0.f;
    float* rope = (float*)(p.ws + WS_ROPE);
    for (int i = gt; i < SEQ * 8; i += NGT) {
        const int pos = i >> 3, j = i & 7;
        const float invf = j == 0 ? 1.0f : j == 1 ? 0.1939227432012558f : j == 2 ? 0.03760603070259094f : j == 3 ? 0.007292664609849453f : j == 4 ? 0.0014142135623842478f
                         : j == 5 ? 0.00027424818836152554f : j == 6 ? 5.318296098266728e-05f : 1.0313386155758053e-05f;
        const float ang = (float)pos * invf; float sv, cv; sincosf(ang, &sv, &cv);
        rope[pos * 16 + j] = cv; rope[pos * 16 + 8 + j] = sv;
    }
}

#ifndef PF_A
#define PF_A true
#endif
#ifndef PF_B
#define PF_B false
#endif
template <int MIX> struct AC;
template <> struct AC<0> { static constexpr int REP = 8, CT = 128, NKV = 2; };
template <> struct AC<1> { static constexpr int REP = 4, CT = 128, NKV = 4; };
constexpr int LACC_OFF = 65536, KST_OFF = 67584, ST_ROWS = 320, VST_OFF = KST_OFF + ST_ROWS * 128, ATT_END = VST_OFF + ST_ROWS * 128;
constexpr int VW_ROW = 144, VW_WAVE = 16 * VW_ROW;
static_assert(ATT_END <= 155584 && 8 * (4096 + VW_WAVE) <= 2 * ST_ROWS * 128, "attention LDS map");

#define ST_SW(row) ((((row) >> 1) & 7) ^ ((((row) >> 1) & 1) << 2))
__device__ __forceinline__ s16x4 vtr(const LAS unsigned char* p) { return __builtin_bit_cast(s16x4, __builtin_amdgcn_ds_read_tr16_b64_v4i16((LAS v4i16_t*)p)); }

#define ATT_QK(SD, GETK)                                                                                                                              \
    {   _Pragma("unroll") for (int i = 0; i < 16; ++i) SD[i] = negM2;                                                                                \
        _Pragma("unroll") for (int s = 0; s < 4; ++s) SD = __builtin_amdgcn_mfma_f32_32x32x16_bf16(GETK(s), qf[s], SD, 0, 0, 0); }
#define ATT_SMPV(KT, S, KF0, QI, MD, GETV, USE_LR, MASKALL, SHORT4)                                                                                           \
    {   float p[16];                                                                                                                                  \
        if ((KT) == 4) { const int t = (QI) - 4 * h;                                                                                                  \
            _Pragma("unroll") for (int i = 0; i < 16; ++i) { const int ci = (i & 3) + 8 * (i >> 2); p[i] = ((SHORT4) && i >= 4) ? 0.f : ((ci <= t) ? __builtin_amdgcn_exp2f(S[i]) : 0.f); } } \
        else if ((MASKALL) || (KT) == 0 || (KF0) < 0) { int lo = 128 + (QI) - 32 * (KT) - (MD); lo = (lo > -(KF0) ? lo : -(KF0)) - 4 * h;             \
            _Pragma("unroll") for (int i = 0; i < 16; ++i) { const int ci = (i & 3) + 8 * (i >> 2); p[i] = (ci >= lo) ? __builtin_amdgcn_exp2f(S[i]) : 0.f; } } \
        else { _Pragma("unroll") for (int i = 0; i < 16; ++i) p[i] = __builtin_amdgcn_exp2f(S[i]); }     \
        _Pragma("unroll") for (int hf = 0; hf < (((KT) == 4 && (SHORT4)) ? 1 : 2); ++hf) {                                                              \
            u32x4 pw; pw.x = pkbf(p[8 * hf + 0], p[8 * hf + 1]); pw.y = pkbf(p[8 * hf + 2], p[8 * hf + 3]); pw.z = pkbf(p[8 * hf + 4], p[8 * hf + 5]); pw.w = pkbf(p[8 * hf + 6], p[8 * hf + 7]); \
            const bf16x8 pb = __builtin_bit_cast(bf16x8, pw);                                                                                         \
            bf16x8 v0, v1; GETV(hf, v0, v1);                                                                                                          \
            O0 = __builtin_amdgcn_mfma_f32_32x32x16_bf16(v0, pb, O0, 0, 0, 0);                                                                        \
            O1 = __builtin_amdgcn_mfma_f32_32x32x16_bf16(v1, pb, O1, 0, 0, 0);                                                                        \
            if (USE_LR) Lr = __builtin_amdgcn_mfma_f32_32x32x16_bf16(ones8, pb, Lr, 0, 0, 0);                                                         \
        }                                                                                                                                             \
        if (!(USE_LR)) { _Pragma("unroll") for (int i = 0; i < 16; ++i) lsum_v += p[i]; } }

template <int MIX, bool DRY = false>
__device__ __forceinline__ void attn_phase(LAS unsigned char* lds, const bf16_t* Qb, const bf16_t* Kb, const bf16_t* Vb, bf16_t* Gb, const float* qg, const float* kg, const float* sinks) {
    constexpr int REP = AC<MIX>::REP, CT = AC<MIX>::CT, NKV = AC<MIX>::NKV, NG = MIX ? 3 : 1, KVW = NKV * 64, NCH = SEQ / CT, NUNITS = 8 * NCH * NKV;
    constexpr int md = (MIX == 0) ? 127 : 128;
    int tid_ = threadIdx.x; asm volatile("" : "+v"(tid_));
    const int tid = tid_, lane0 = tid & 63, wave = __builtin_amdgcn_readfirstlane(tid >> 6);
    LAS unsigned char* Oacc = lds; LAS float* lacc = (LAS float*)(lds + LACC_OFF); LAS unsigned char* Kst = lds + KST_OFF; LAS unsigned char* Vst = lds + VST_OFF;
    LAS unsigned char* kwv = Kst + wave * (4096 + VW_WAVE); LAS unsigned char* vwv = kwv + 4096;
    float Mb = 0.f;
#pragma unroll
    for (int g = 0; g < NG; ++g) { float mq = fabsf(qg[g * 64 + lane0]), mk = fabsf(kg[g * 64 + lane0]);
#pragma unroll
        for (int o = 1; o < 64; o <<= 1) { mq = fmaxf(mq, __shfl_xor(mq, o)); mk = fmaxf(mk, __shfl_xor(mk, o)); }
        Mb = fmaxf(Mb, 8.0f * mq * mk); }
#define UNIT_MAP(U) ((gridDim.x == 256) ? ((((U) & 255) & 7) * (NUNITS / 8) + ((U) >> 8) * 32 + (((U) & 255) >> 3)) : (U))
#define STAGE_LOAD(U, ST) { const int u_ = UNIT_MAP(U), st_ = (ST); const int chunk_ = u_ % NCH, kvh_ = (u_ / NCH) % NKV, b_ = u_ / (NKV * NCH); const int t0_ = chunk_ * CT; const long rowb_ = (long)b_ * SEQ; \
        const int g_ = (st_ == 0) ? 0 : 1; const bf16_t* Kg_ = Kb + (size_t)g_ * NTOK * KVW + kvh_ * 64; const bf16_t* Vg_ = Vb + (size_t)g_ * NTOK * KVW + kvh_ * 64; \
        const int nrows_ = MIX == 0 ? 256 : (st_ == 0 ? 256 : 320); int tl_ = tid; asm volatile("" : "+v"(tl_)); const int lrow_ = tl_ >> 3, lch_ = tl_ & 7; \
        _Pragma("unroll") for (int j = 0; j < NJ; ++j) { int i = lrow_ + 64 * j; i = i < nrows_ ? i : nrows_ - 1;     \
            { long tok; if (st_ == 0) tok = t0_ - 128 + i; else { const int rl = i >= 160 ? 1 : 0, ii = i - 160 * rl; tok = t0_ + (2 * (st_ - 1) + rl) - 512 + 4 * ii; } \
                kreg[j] = *(const u32x4*)(Kg_ + (rowb_ + tok) * KVW + 8 * lch_); vreg[j] = *(const u32x4*)(Vg_ + (rowb_ + tok) * KVW + 8 * lch_); } } }
#define STAGE_STORE(ST) { const int st_ = (ST); const int nrows_ = MIX == 0 ? 256 : (st_ == 0 ? 256 : 320); int tl_ = tid; asm volatile("" : "+v"(tl_)); const int lrow_ = tl_ >> 3, lch_ = tl_ & 7; \
        _Pragma("unroll") for (int j = 0; j < NJ; ++j) { const int i = lrow_ + 64 * j; \
            if (i < nrows_) { const int o = i * 128 + ((lch_ ^ ST_SW(i)) << 4); *(LAS u32x4*)(Kst + o) = kreg[j]; *(LAS u32x4*)(Vst + o) = vreg[j]; } } }
    constexpr int NJ = MIX == 0 ? 4 : 5;
    constexpr bool PF = (MIX == 0) ? PF_A : PF_B;
    u32x4 kreg[NJ], vreg[NJ];
    if ((PF || MIX == 1) && (int)blockIdx.x < NUNITS) STAGE_LOAD(blockIdx.x, 0)
    if (MIX == 1 && (int)blockIdx.x < NUNITS) STAGE_STORE(0)
    for (int unit = blockIdx.x; unit < NUNITS; unit += gridDim.x) {
        int tidu = tid; asm volatile("" : "+v"(tidu));
        const int lane = tidu & 63, r = lane & 31, h = lane >> 5;
    const bf16x8 ones8 = {0x3F80, 0x3F80, 0x3F80, 0x3F80, 0x3F80, 0x3F80, 0x3F80, 0x3F80};
    const int trq = (lane & 15) >> 2, trp = lane & 3, trg = (lane >> 4) & 1;
    int koff[4];
#pragma unroll
    for (int s = 0; s < 4; ++s) koff[s] = r * 128 + (((2 * s + h) ^ ST_SW(r)) << 4);
    const int vrl = 4 * h + trq, vrh = vrl + 8;
    const int voff0 = vrl * 128 + (((2 * trg + (trp >> 1)) ^ ST_SW(vrl)) << 4) + 8 * (trp & 1);
    const int voff1 = vrl * 128 + (((4 + 2 * trg + (trp >> 1)) ^ ST_SW(vrl)) << 4) + 8 * (trp & 1);
    const int voff0h = vrh * 128 + (((2 * trg + (trp >> 1)) ^ ST_SW(vrh)) << 4) + 8 * (trp & 1);
    const int voff1h = vrh * 128 + (((4 + 2 * trg + (trp >> 1)) ^ ST_SW(vrh)) << 4) + 8 * (trp & 1);
    const int vkey = lane >> 3, vchunk = lane & 7;
    const int tr_lo = (4 * h + trq) * VW_ROW + (16 * trg + 4 * trp) * 2, tr_hi = tr_lo + 8 * VW_ROW;
    const int lrow = tidu >> 3, lchunk = tidu & 7;

        const int um = UNIT_MAP(unit); const int chunk = um % NCH, kvh = (um / NCH) % NKV, b = um / (NKV * NCH);
        const int t0 = chunk * CT; const long rowb = (long)b * SEQ;
        constexpr int NSTAGE = MIX ? 3 : 1;
#pragma unroll 1
        for (int st = 0; st < NSTAGE; ++st) {
            const int g = (st == 0) ? 0 : 1, dil = (st == 0) ? 1 : 4;
            const bf16_t* Qg = Qb + (size_t)g * NTOK * 1024;
            const bf16_t* Kg = Kb + (size_t)g * NTOK * KVW + kvh * 64;
            const bf16_t* Vg = Vb + (size_t)g * NTOK * KVW + kvh * 64;
            const int nrows = MIX == 0 ? 256 : (st == 0 ? 256 : 320);
            const int ntask = MIX == 0 ? 32 : (st == 0 ? 16 : 8);
            constexpr bool PRE0 = (MIX == 1);
            if (!PF && !(PRE0 && st == 0)) STAGE_LOAD(unit, st)
#define TASK_DECODE(T) int hr, tl, f0, tb0; { const int t_ = (T); \
                if (MIX == 0) { hr = t_ >> 2; const int sub = t_ & 3; tl = 32 * sub + r; f0 = t0 + 32 * sub; tb0 = 32 * sub; } \
                else if (st == 0) { hr = t_ >> 2; const int sub = t_ & 3; tl = 32 * sub + r; f0 = t0 + 32 * sub; tb0 = 32 * sub; } \
                else { hr = t_ >> 1; const int rl = t_ & 1; tl = 2 * (st - 1) + rl + 4 * r; f0 = t0 >> 2; tb0 = 160 * rl; } }
            bf16x8 qn[4];
            { TASK_DECODE(wave) (void)f0; (void)tb0; const bf16_t* qp_ = Qg + (rowb + t0 + tl) * 1024 + (kvh * REP + hr) * 64 + 8 * h;
#pragma unroll
              for (int s = 0; s < 4; ++s) qn[s] = *(const bf16x8*)(qp_ + 16 * s); }
            if (!(PRE0 && st == 0)) {
                __syncthreads();
                STAGE_STORE(st)
            }
            __syncthreads();
            if (PF) { if (st + 1 < NSTAGE) STAGE_LOAD(unit, st + 1)
                      else if (MIX == 0 && unit + (int)gridDim.x < NUNITS) STAGE_LOAD(unit + (int)gridDim.x, 0) }
#pragma unroll 1
            for (int task = wave; task < ntask; task += 8) {
                TASK_DECODE(task)
                const int qi = r, head = kvh * REP + hr;
                float M2 = Mb * LOG2E; if (MIX == 0) M2 = fmaxf(Mb, sinks[head]) * LOG2E;
                const float negM2 = -M2;
                bf16x8 qf[4];
#pragma unroll
                for (int s = 0; s < 4; ++s) qf[s] = qn[s];
                if (task + 8 < ntask) { const int t2_ = task + 8; int hr2, tl2;
                    hr2 = t2_ >> 2; tl2 = 32 * (t2_ & 3) + r;
                    const bf16_t* qp_ = Qg + (rowb + t0 + tl2) * 1024 + (kvh * REP + hr2) * 64 + 8 * h;
#pragma unroll
                    for (int s = 0; s < 4; ++s) qn[s] = *(const bf16x8*)(qp_ + 16 * s); }
                f32x16 O0, O1, Lr; float lsum_v = 0.f;
#pragma unroll
                for (int i = 0; i < 16; ++i) { O0[i] = 0.f; O1[i] = 0.f; Lr[i] = 0.f; }
                const LAS unsigned char* kbs[4]; const LAS unsigned char* vbs[4];
#pragma unroll
                for (int s = 0; s < 4; ++s) kbs[s] = Kst + tb0 * 128 + koff[s];
                vbs[0] = Vst + tb0 * 128 + voff0; vbs[1] = Vst + tb0 * 128 + voff0h; vbs[2] = Vst + tb0 * 128 + voff1; vbs[3] = Vst + tb0 * 128 + voff1h;
                f32x16 S2[2];
#define GETK_S0(s) (*(const LAS bf16x8*)(kbs[s]))
                ATT_QK(S2[0], GETK_S0)
#pragma unroll
                for (int kt = 0; kt < 5; ++kt) {
                    const int kf0 = f0 - 128 + 32 * kt;
#define GETK_S(s) (*(const LAS bf16x8*)(kbs[s] + (kt + 1) * 4096))
                    if (kt < 4) ATT_QK(S2[(kt + 1) & 1], GETK_S)
#define GETV_S(hf, v0, v1) { const s16x4 a0 = vtr(vbs[0] + kt * 4096 + (hf) * 2048), a1 = vtr(vbs[1] + kt * 4096 + (hf) * 2048), b0 = vtr(vbs[2] + kt * 4096 + (hf) * 2048), b1 = vtr(vbs[3] + kt * 4096 + (hf) * 2048); \
                             v0 = __builtin_shufflevector(a0, a1, 0, 1, 2, 3, 4, 5, 6, 7); v1 = __builtin_shufflevector(b0, b1, 0, 1, 2, 3, 4, 5, 6, 7); }
                    ATT_SMPV(kt, S2[kt & 1], kf0, qi, md, GETV_S, (MIX == 1), false, false)
                }
                const float lsum = (MIX == 1) ? Lr[0] : lsum_v + __shfl_xor(lsum_v, 32);
                if (MIX == 0) {
                    if (!DRY) {
                        const float sk = sinks[head]; const float inv = 1.0f / (lsum + __builtin_amdgcn_exp2f((sk - fmaxf(Mb, sk)) * LOG2E));
                        bf16_t* gp = Gb + (rowb + t0 + tl) * 1024 + head * 64 + 4 * h;
#pragma unroll
                        for (int gq = 0; gq < 4; ++gq) {
                            const u32x2 g0 = *(const u32x2*)(gp + 8 * gq), g1 = *(const u32x2*)(gp + 32 + 8 * gq);
                            u32x2 w0, w1;
                            w0.x = pkbf(O0[4 * gq] * inv * bflo(g0.x), O0[4 * gq + 1] * inv * bfhi(g0.x)); w0.y = pkbf(O0[4 * gq + 2] * inv * bflo(g0.y), O0[4 * gq + 3] * inv * bfhi(g0.y));
                            w1.x = pkbf(O1[4 * gq] * inv * bflo(g1.x), O1[4 * gq + 1] * inv * bfhi(g1.x)); w1.y = pkbf(O1[4 * gq + 2] * inv * bflo(g1.y), O1[4 * gq + 3] * inv * bfhi(g1.y));
                            *(u32x2*)(gp + 8 * gq) = w0; *(u32x2*)(gp + 32 + 8 * gq) = w1;
                        }
                    }
                } else {
                    const int row = hr * CT + tl, f = ((tl >> 1) ^ (tl >> 4) ^ (hr << 2)) & 15;
                    LAS unsigned char* orow = Oacc + row * 128;
#pragma unroll
                    for (int gq = 0; gq < 4; ++gq) {
                        LAS u32x2* p0 = (LAS u32x2*)(orow + (((2 * gq + h) ^ f) << 3)); LAS u32x2* p1 = (LAS u32x2*)(orow + (((8 + 2 * gq + h) ^ f) << 3));
                        float a0 = O0[4 * gq], a1 = O0[4 * gq + 1], a2 = O0[4 * gq + 2], a3 = O0[4 * gq + 3], c0 = O1[4 * gq], c1 = O1[4 * gq + 1], c2 = O1[4 * gq + 2], c3 = O1[4 * gq + 3];
                        if (st > 0) { const u32x2 x = *p0, y = *p1; a0 += bflo(x.x); a1 += bfhi(x.x); a2 += bflo(x.y); a3 += bfhi(x.y); c0 += bflo(y.x); c1 += bfhi(y.x); c2 += bflo(y.y); c3 += bfhi(y.y); }
                        u32x2 w0, w1; w0.x = pkbf(a0, a1); w0.y = pkbf(a2, a3); w1.x = pkbf(c0, c1); w1.y = pkbf(c2, c3);
                        *p0 = w0; *p1 = w1;
                    }
                    if (h == 0) { float lv = lsum; if (st > 0) lv += lacc[row]; lacc[row] = lv; }
                }
            }
        }
        if (MIX == 1) {
            __syncthreads();
            constexpr int g = 2, dil = 16;
            const bf16_t* Qg = Qb + (size_t)g * NTOK * 1024;
            const bf16_t* Kg = Kb + (size_t)g * NTOK * KVW + kvh * 64;
            const bf16_t* Vg = Vb + (size_t)g * NTOK * KVW + kvh * 64;
#pragma unroll 1
            for (int task = wave; task < 16; task += 8) {
                const int res = task, hr = r >> 3, qi = r & 7, tl = res + 16 * qi, f0 = t0 >> 4, head = kvh * REP + hr;
                const float negM2 = -Mb * LOG2E;
                const bf16_t* qptr = Qg + (rowb + t0 + tl) * 1024 + head * 64 + 8 * h;
                bf16x8 qf[4];
#pragma unroll
                for (int s = 0; s < 4; ++s) qf[s] = *(const bf16x8*)(qptr + 16 * s);
                const long kstep = (long)32 * dil * KVW, vstep8 = (long)8 * dil * KVW;
                const bf16_t* kp = Kg + (rowb + res + (long)dil * (f0 - 128 + vkey)) * KVW + 8 * vchunk;
                const bf16_t* vp = Vg + (rowb + res + (long)dil * (f0 - 128 + vkey)) * KVW + 8 * vchunk;
                f32x16 O0, O1, Lr;
#pragma unroll
                for (int i = 0; i < 16; ++i) { O0[i] = 0.f; O1[i] = 0.f; Lr[i] = 0.f; }
                float lsum_v = 0.f; (void)lsum_v;
                bf16x8 kb[3][4]; u32x4 vb[3][4];
#pragma unroll
                for (int t = 0; t < 3; ++t) {
#pragma unroll
                    for (int s = 0; s < 4; ++s) kb[t][s] = *(const bf16x8*)(kp + t * kstep + s * vstep8);
#pragma unroll
                    for (int j = 0; j < 4; ++j) vb[t][j] = *(const u32x4*)(vp + t * kstep + j * vstep8);
                }
                __builtin_amdgcn_sched_barrier(0);
#define GETK_D(s) (*(const LAS bf16x8*)(kwv + koff[s]))
#define STAGE_K_D(T) { _Pragma("unroll") for (int j = 0; j < ((T) == 4 ? 1 : 4); ++j) *(LAS bf16x8*)(kwv + (8 * j + vkey) * 128 + ((vchunk ^ ST_SW(8 * j + vkey)) << 4)) = kb[(T) % 3][j]; }
                f32x16 S2[2];
                STAGE_K_D(0) ATT_QK(S2[0], GETK_D)
#pragma unroll
                for (int kt = 0; kt < 5; ++kt) {
                    const int kf0 = f0 - 128 + 32 * kt;
                    if (kt < 4) { STAGE_K_D(kt + 1) ATT_QK(S2[(kt + 1) & 1], GETK_D) }
#define GETV_D(hf, v0, v1) { *(LAS u32x4*)(vwv + (vkey) * VW_ROW + vchunk * 16) = vb[kt % 3][2 * (hf)]; if (kt != 4) *(LAS u32x4*)(vwv + (8 + vkey) * VW_ROW + vchunk * 16) = vb[kt % 3][2 * (hf) + 1]; \
                             const s16x4 a0 = vtr(vwv + tr_lo), a1 = vtr(vwv + tr_hi), b0 = vtr(vwv + tr_lo + 64), b1 = vtr(vwv + tr_hi + 64); \
                             v0 = __builtin_shufflevector(a0, a1, 0, 1, 2, 3, 4, 5, 6, 7); v1 = __builtin_shufflevector(b0, b1, 0, 1, 2, 3, 4, 5, 6, 7); }
                    ATT_SMPV(kt, S2[kt & 1], kf0, qi, md, GETV_D, true, true, true)
                    __builtin_amdgcn_sched_barrier(0);
                    if (kt + 3 < 5) {
#pragma unroll
                        for (int s = 0; s < (kt + 3 == 4 ? 1 : 4); ++s) kb[kt % 3][s] = *(const bf16x8*)(kp + (kt + 3) * kstep + s * vstep8);
#pragma unroll
                        for (int j = 0; j < (kt + 3 == 4 ? 1 : 4); ++j) vb[kt % 3][j] = *(const u32x4*)(vp + (kt + 3) * kstep + j * vstep8);
                    }
                    __builtin_amdgcn_sched_barrier(0);
                }
                const float lsum = Lr[0];
                const int row = hr * CT + tl, f = ((tl >> 1) ^ (tl >> 4) ^ (hr << 2)) & 15;
                LAS unsigned char* orow = Oacc + row * 128;
#pragma unroll
                for (int gq = 0; gq < 4; ++gq) {
                    LAS u32x2* p0 = (LAS u32x2*)(orow + (((2 * gq + h) ^ f) << 3)); LAS u32x2* p1 = (LAS u32x2*)(orow + (((8 + 2 * gq + h) ^ f) << 3));
                    const u32x2 x = *p0, y = *p1;
                    u32x2 w0, w1; w0.x = pkbf(O0[4 * gq] + bflo(x.x), O0[4 * gq + 1] + bfhi(x.x)); w0.y = pkbf(O0[4 * gq + 2] + bflo(x.y), O0[4 * gq + 3] + bfhi(x.y));
                    w1.x = pkbf(O1[4 * gq] + bflo(y.x), O1[4 * gq + 1] + bfhi(y.x)); w1.y = pkbf(O1[4 * gq + 2] + bflo(y.y), O1[4 * gq + 3] + bfhi(y.y));
                    *p0 = w0; *p1 = w1;
                }
                if (h == 0) lacc[row] += lsum;
            }
            __syncthreads();
            const bool more = unit + (int)gridDim.x < NUNITS;
            STAGE_LOAD(more ? unit + (int)gridDim.x : unit, 0)
#pragma unroll 4
            for (int it = 0; it < (DRY ? 0 : 8); ++it) {
                const int item = it * 512 + tidu, row = item >> 3, dg = item & 7, hr = row / CT, tl = row % CT;
                const int f = ((tl >> 1) ^ (tl >> 4) ^ (hr << 2)) & 15, head = kvh * REP + hr;
                const LAS unsigned char* orow = Oacc + row * 128;
                const u32x2 o0 = *(const LAS u32x2*)(orow + (((2 * dg) ^ f) << 3)), o1 = *(const LAS u32x2*)(orow + (((2 * dg + 1) ^ f) << 3));
                const float inv = 1.0f / lacc[row];
                u32x4* gp = (u32x4*)(Gb + (rowb + t0 + tl) * 1024 + head * 64 + 8 * dg);
                const u32x4 gv = *gp;
                u32x4 w;
                w.x = pkbf(bflo(o0.x) * inv * bflo(gv.x), bfhi(o0.x) * inv * bfhi(gv.x)); w.y = pkbf(bflo(o0.y) * inv * bflo(gv.y), bfhi(o0.y) * inv * bfhi(gv.y));
                w.z = pkbf(bflo(o1.x) * inv * bflo(gv.z), bfhi(o1.x) * inv * bfhi(gv.z)); w.w = pkbf(bflo(o1.y) * inv * bflo(gv.w), bfhi(o1.y) * inv * bfhi(gv.w));
                *gp = w;
            }
            if (more) STAGE_STORE(0)
        }
    }
    __syncthreads();
}

__global__ void __launch_bounds__(512, 2) mega_fwd(Params p) {
    extern __shared__ __attribute__((aligned(16))) unsigned char lds_raw[];
    LAS unsigned char* lds = (LAS unsigned char*)lds_raw;
    cg::grid_group grid = cg::this_grid();
    bf16_t* WinA = (bf16_t*)(p.ws + WS_WINA); bf16_t* WinB = (bf16_t*)(p.ws + WS_WINB); bf16_t* Wout = (bf16_t*)(p.ws + WS_WOUT);
    bf16_t* xb = (bf16_t*)(p.ws + WS_XB); float* rowsq = (float*)(p.ws + WS_ROWSQ); const float* rope = (const float*)(p.ws + WS_ROPE);
    bf16_t* Qb = (bf16_t*)(p.ws + WS_Q); bf16_t* Kb = (bf16_t*)(p.ws + WS_K); bf16_t* Vb = (bf16_t*)(p.ws + WS_V); bf16_t* Gb = (bf16_t*)(p.ws + WS_G);
    volatile LAS unsigned* misc = (volatile LAS unsigned*)(lds + MISC_OFF);
    if (threadIdx.x < 2) misc[threadIdx.x] = 0u;
    __syncthreads();
    const XcdBarrier bar = xcd_barrier_post((unsigned*)(p.ws + WS_CTL), misc);
    prologue<0>(p, lds);
    xcd_barrier(bar);
    if (p.ws == nullptr) grid.sync();
#pragma unroll 1
    for (int layer = 0; layer < 4; ++layer) {
        const int idx = layer >> 1, mixer = layer & 1;
        {
            const int N = mixer ? NB : NA;
            pg8::Gemm g{xb, mixer ? WinB + (size_t)idx * NB * DM : WinA + (size_t)idx * NA * DM, NTOK, N, DM};
            pg8::StaticOrder S; S.init(NTOK, N, (int)gridDim.x, (int)blockIdx.x);
            EpiIn E{mixer, rowsq + (size_t)layer * NTOK, mixer ? p.q_gain_b + idx * 192 : p.q_gain_a + idx * 64, mixer ? p.k_gain_b + idx * 192 : p.k_gain_a + idx * 64, rope, Qb, Kb, Vb, Gb};
            pg8::gemm_phase<EpiIn, pg8::StaticOrder, true, true>(lds, g, S, E);
#ifdef PROBE_GEMM2
            pg8::gemm_phase<EpiIn, pg8::StaticOrder, true, true>(lds, g, S, E);
#endif
        }
        xcd_barrier(bar);
#ifdef PROBE_ATTN2
#if PROBE_ATTN2 == 2
        if (!mixer) attn_phase<0, true>(lds, Qb, Kb, Vb, Gb, p.q_gain_a + idx * 64, p.k_gain_a + idx * 64, p.sinks_a + idx * 16);
#else
        if (mixer) attn_phase<1, true>(lds, Qb, Kb, Vb, Gb, p.q_gain_b + idx * 192, p.k_gain_b + idx * 192, nullptr);
        else       attn_phase<0, true>(lds, Qb, Kb, Vb, Gb, p.q_gain_a + idx * 64, p.k_gain_a + idx * 64, p.sinks_a + idx * 16);
#endif
#endif
        if (mixer) attn_phase<1>(lds, Qb, Kb, Vb, Gb, p.q_gain_b + idx * 192, p.k_gain_b + idx * 192, nullptr);
        else       attn_phase<0>(lds, Qb, Kb, Vb, Gb, p.q_gain_a + idx * 64, p.k_gain_a + idx * 64, p.sinks_a + idx * 16);
        xcd_barrier(bar);
        {
            pg8::Gemm g{Gb, Wout + (size_t)layer * DM * DM, NTOK, DM, DM};
            pg8::StaticOrder S; S.init(NTOK, DM, (int)gridDim.x, (int)blockIdx.x);
            EpiOut E{layer == 0 ? p.x : nullptr, xb, p.ws + WS_LO8, layer == 3 ? p.out : nullptr, layer < 3 ? rowsq + (size_t)(layer + 1) * NTOK : rowsq};
            pg8::gemm_phase<EpiOut, pg8::StaticOrder, true, true>(lds, g, S, E);
        }
        if (layer < 3) xcd_barrier(bar);
    }
}

extern "C" void kernel_launch(void* const* d_in, const int* in_sizes, int n_in, void* d_out, int out_size, void* d_ws, size_t ws_size, hipStream_t stream) {
    static int grid = 0;
    if (grid == 0) {
        if (n_in != 12 || out_size != NTOK * DM || ws_size < WS_END) { fprintf(stderr, "kernel_launch: unexpected shapes (n_in %d out %d ws %zu)\n", n_in, out_size, ws_size); grid = -1; return; }
        int dev = 0, cus = 0, per_cu = 0;
        hipGetDevice(&dev); hipDeviceGetAttribute(&cus, hipDeviceAttributeMultiprocessorCount, dev);
        if (hipFuncSetAttribute((const void*)mega_fwd, hipFuncAttributeMaxDynamicSharedMemorySize, LDS_BYTES) != hipSuccess) { fprintf(stderr, "kernel_launch: hipFuncSetAttribute failed\n"); grid = -1; return; }
        if (hipOccupancyMaxActiveBlocksPerMultiprocessor(&per_cu, (const void*)mega_fwd, 512, LDS_BYTES) != hipSuccess || per_cu < 1) { fprintf(stderr, "kernel_launch: occupancy query failed (%d)\n", per_cu); (void)hipGetLastError(); per_cu = 1; }
        grid = cus * per_cu;
    }
    if (grid < 0) return;
    if (hipMemsetAsync((char*)d_ws + WS_CTL, 0, CTL_BYTES, stream) != hipSuccess) { fprintf(stderr, "kernel_launch: memset failed\n"); return; }
    Params p{};
    p.x = (const float*)d_in[0]; p.norm_a = (const float*)d_in[1]; p.w_in_a = (const float*)d_in[2]; p.q_gain_a = (const float*)d_in[3]; p.k_gain_a = (const float*)d_in[4];
    p.sinks_a = (const float*)d_in[5]; p.w_out_a = (const float*)d_in[6]; p.norm_b = (const float*)d_in[7]; p.w_in_b = (const float*)d_in[8]; p.q_gain_b = (const float*)d_in[9];
    p.k_gain_b = (const float*)d_in[10]; p.w_out_b = (const float*)d_in[11]; p.out = (float*)d_out; p.ws = (unsigned char*)d_ws;
    void* args[] = {&p};
    hipError_t e = hipLaunchCooperativeKernel((const void*)mega_fwd, dim3(grid), dim3(512), args, LDS_BYTES, stream);
    if (e != hipSuccess) fprintf(stderr, "kernel_launch: cooperative launch failed: %s (grid %d)\n", hipGetErrorString(e), grid);
}
```

```cpp
#include <hip/hip_runtime.h>
#include <hip/hip_cooperative_groups.h>
#include <cstdio>
#include <cstdint>
namespace cg = cooperative_groups;
namespace pg8 {
#define PG8_LAS __attribute__((address_space(3)))
typedef unsigned short bf16_t;
typedef short bf16x8 __attribute__((ext_vector_type(8)));
typedef float f32x4 __attribute__((ext_vector_type(4)));
typedef unsigned u32x4 __attribute__((ext_vector_type(4)));
constexpr int BM = 256, BK = 64, HALF = 128, HTB = HALF * BK * 2  , STAGE_BYTES = 8 * HTB, NXCD = 8, WGM = 4;

__host__ __device__ __forceinline__ int lds_byte(int r, int c) { const int st = (r >> 4) * 2 + (c >> 5), rr = r & 15, cc = c & 31, ob = rr * 64 + cc * 2; return st * 1024 + (ob ^ (((ob >> 9) & 1) << 5)); }
__host__ __device__ __forceinline__ void stage_rc(int b, int& R, int& C) { const int st = b / 1024, sb = b % 1024, swz = sb ^ (((sb >> 9) & 1) << 5); R = (st >> 1) * 16 + swz / 64; C = (st & 1) * 32 + (swz % 64) / 2; }
__host__ __device__ __forceinline__ int perm32(int rho) { const int n = rho >> 4, i = rho & 15; return 8 * (i >> 2) + 4 * n + (i & 3); }

struct Unit { int pm, pn; };
struct Gemm { const bf16_t* A; const bf16_t* Bt; int M, N, K; };

struct StaticOrder {
    int nM, nN, nwg, G, c;
    __host__ __device__ void init(int M, int N, int G_, int c_) { nM = M / BM; nN = N / BM; nwg = nM * nN; G = G_; c = c_; }
    __host__ __device__ bool next(int i, Unit& u) const {
        const long L = (long)i * G + c; if (L >= nwg) return false;
        int wgid = (int)L; { const int q = nwg / NXCD, r = nwg % NXCD, xcd = wgid % NXCD, off = wgid / NXCD; wgid = (xcd < r ? xcd * (q + 1) : r * (q + 1) + (xcd - r) * q) + off; }
        const int nig = WGM * nN, gid = wgid / nig, fm = gid * WGM, gsz = (nM - fm) < WGM ? (nM - fm) : WGM;
        u.pm = fm + ((wgid % nig) % gsz); u.pn = (wgid % nig) / gsz; return true;
    }
    __device__ __forceinline__ void a_ready(const Unit&) const {}
    __device__ __forceinline__ void done(const Unit&) const {}
};

__device__ __forceinline__ unsigned cvt_pk_bf16(float lo, float hi) { unsigned r; asm volatile("v_cvt_pk_bf16_f32 %0, %1, %2" : "=v"(r) : "v"(lo), "v"(hi)); return r; }
typedef float f32x2 __attribute__((ext_vector_type(2)));
template <class Epi, class Sched, bool ALIGN_EPI = false, bool SP2 = false>
__device__ __forceinline__ void gemm_phase(PG8_LAS unsigned char* lds, const Gemm g, const Sched& S, const Epi& E) {
    int tid_ = threadIdx.x; asm volatile("" : "+v"(tid_));
    const int tid = tid_, wid = __builtin_amdgcn_readfirstlane(tid >> 6), lane = tid & 63, wr = wid >> 2, wc = wid & 3, fr = lane & 15, fq = lane >> 4;
    const int K = g.K, nt = K / BK;
    unsigned voffA[2], voffB[2];
#pragma unroll
    for (int i = 0; i < 2; ++i) { int R, C; stage_rc(tid * 16 + i * 8192, R, C); const int Rb = Epi::PERM ? ((R & ~31) + perm32(R & 31)) : R;
        voffA[i] = (unsigned)(R * K + C) * 2u; voffB[i] = (unsigned)(Rb * K + C) * 2u; }
    const size_t kstep = (size_t)(BK * 2);
    const size_t hstep = (size_t)HALF * K * 2;
    const size_t tstep = 2 * hstep;
    const unsigned ldsw = (unsigned)wid * 1024u;
    const int aoff = lds_byte(wr * 64 + fr, fq * 8), boff = lds_byte(wc * 32 + fr, fq * 8);
#define PG8_SA(b, h) (((b) * 2 + (h)) * HTB)
#define PG8_SB(b, h) ((4 + (b) * 2 + (h)) * HTB)
#define PG8_STAGE(bufoff, gbase, voff) do { _Pragma("unroll") for (int _i = 0; _i < 2; ++_i) \
        __builtin_amdgcn_global_load_lds((const unsigned*)((const char*)(gbase) + (voff)[_i]), (PG8_LAS unsigned*)(lds + (bufoff) + ldsw + _i * 8192), 16, 0, 0); } while (0)
#define PG8_LDA(dst, b, h) do { _Pragma("unroll") for (int m = 0; m < 4; ++m) _Pragma("unroll") for (int k = 0; k < 2; ++k) dst[m][k] = *(const PG8_LAS bf16x8*)(lds + PG8_SA(b, h) + aoff + m * 2048 + k * 1024); } while (0)
#define PG8_LDB(dst, b, h) do { _Pragma("unroll") for (int n = 0; n < 2; ++n) _Pragma("unroll") for (int k = 0; k < 2; ++k) dst[n][k] = *(const PG8_LAS bf16x8*)(lds + PG8_SB(b, h) + boff + n * 2048 + k * 1024); } while (0)
#define PG8_MMA(ai, bj, At, Bt) do { __builtin_amdgcn_s_setprio(1); _Pragma("unroll") for (int m = 0; m < 4; ++m) _Pragma("unroll") for (int n = 0; n < 2; ++n) _Pragma("unroll") for (int k = 0; k < 2; ++k) \
        acc[ai][bj][m][n] = __builtin_amdgcn_mfma_f32_16x16x32_bf16(Bt[n][k], At[m][k], acc[ai][bj][m][n], 0, 0, 0); __builtin_amdgcn_s_setprio(0); } while (0)
#define PG8_WAIT_V(n) asm volatile("s_waitcnt vmcnt(" #n ")" ::: "memory")
#define PG8_WAIT_L(n) asm volatile("s_waitcnt lgkmcnt(" #n ")" ::: "memory")
#define PG8_BAR __builtin_amdgcn_s_barrier()
#define PG8_SCHED __builtin_amdgcn_sched_barrier(0)
    Unit cur, nxt; int ui = 0;
    if (!S.next(0, cur)) return;
    f32x4 acc[2][2][4][2];
#pragma unroll
    for (int a = 0; a < 2; ++a)
#pragma unroll
        for (int b = 0; b < 2; ++b)
#pragma unroll
            for (int m = 0; m < 4; ++m)
#pragma unroll
                for (int n = 0; n < 2; ++n) acc[a][b][m][n] = (f32x4){0.f, 0.f, 0.f, 0.f};
    bf16x8 At[4][2], B0[2][2], B1[2][2];
    const char* cA = (const char*)g.A + (size_t)cur.pm * tstep; const char* cB = (const char*)g.Bt + (size_t)cur.pn * tstep;
    S.a_ready(cur);
    if constexpr (SP2) {
        PG8_STAGE(PG8_SB(0, 0), cB, voffB); PG8_STAGE(PG8_SB(0, 1), cB + hstep, voffB); PG8_STAGE(PG8_SA(0, 0), cA, voffA); PG8_STAGE(PG8_SA(0, 1), cA + hstep, voffA);
        if (wr == 1) PG8_BAR;
        PG8_WAIT_V(2); PG8_BAR;
        PG8_STAGE(PG8_SB(1, 0), cB + kstep, voffB); PG8_STAGE(PG8_SA(1, 0), cA + kstep, voffA); PG8_STAGE(PG8_SB(1, 1), cB + hstep + kstep, voffB);
        PG8_WAIT_V(6); PG8_BAR;
    } else {
        PG8_STAGE(PG8_SB(0, 0), cB, voffB); PG8_STAGE(PG8_SA(0, 0), cA, voffA); PG8_STAGE(PG8_SB(0, 1), cB + hstep, voffB); PG8_STAGE(PG8_SA(0, 1), cA + hstep, voffA);
        if (wr == 1) PG8_BAR;
        PG8_WAIT_V(4); PG8_BAR;
        PG8_STAGE(PG8_SB(1, 0), cB + kstep, voffB); PG8_STAGE(PG8_SA(1, 0), cA + kstep, voffA); PG8_STAGE(PG8_SB(1, 1), cB + hstep + kstep, voffB);
        PG8_WAIT_V(6); PG8_BAR;
    }
    for (;;) {
        const bool has_next = S.next(ui + 1, nxt);
        const char* nA = has_next ? (const char*)g.A + (size_t)nxt.pm * tstep : cA; const char* nB = has_next ? (const char*)g.Bt + (size_t)nxt.pn * tstep : cB;
        for (int t = 0; t < nt; t += 2) {
            const bool last = (t == nt - 2);
            const char* a1 = cA + (size_t)(t + 1) * kstep;
            const char* a2 = last ? nA : cA + (size_t)(t + 2) * kstep; const char* b2 = last ? nB : cB + (size_t)(t + 2) * kstep;
            const char* a3 = a2 + kstep; const char* b3 = b2 + kstep;
            if (last && has_next) S.a_ready(nxt);
            if constexpr (SP2) {
            PG8_LDB(B0, 0, 0); PG8_LDB(B1, 0, 1); PG8_SCHED; PG8_LDA(At, 0, 0); PG8_STAGE(PG8_SA(1, 1), a1 + hstep, voffA);
            PG8_WAIT_V(8); PG8_WAIT_L(0); PG8_BAR; PG8_MMA(0, 0, At, B0); PG8_MMA(0, 1, At, B1); PG8_BAR; PG8_SCHED;
            PG8_LDA(At, 0, 1); PG8_STAGE(PG8_SB(0, 0), b2, voffB); PG8_STAGE(PG8_SB(0, 1), b2 + hstep, voffB); PG8_STAGE(PG8_SA(0, 0), a2, voffA);
            PG8_WAIT_V(8); PG8_WAIT_L(0); PG8_BAR; PG8_MMA(1, 0, At, B0); PG8_MMA(1, 1, At, B1); PG8_BAR; PG8_SCHED;
            PG8_LDB(B0, 1, 0); PG8_LDB(B1, 1, 1); PG8_SCHED; PG8_LDA(At, 1, 0); PG8_STAGE(PG8_SA(0, 1), a2 + hstep, voffA);
            PG8_WAIT_V(8); PG8_WAIT_L(0); PG8_BAR; PG8_MMA(0, 0, At, B0); PG8_MMA(0, 1, At, B1); PG8_BAR; PG8_SCHED;
            PG8_LDA(At, 1, 1); PG8_STAGE(PG8_SB(1, 0), b3, voffB); PG8_STAGE(PG8_SB(1, 1), b3 + hstep, voffB); PG8_STAGE(PG8_SA(1, 0), a3, voffA);
            PG8_WAIT_V(8); PG8_WAIT_L(0); PG8_BAR; PG8_MMA(1, 0, At, B0); PG8_MMA(1, 1, At, B1); PG8_BAR; PG8_SCHED;
            } else {
            PG8_LDB(B0, 0, 0); PG8_SCHED; PG8_LDA(At, 0, 0); PG8_STAGE(PG8_SA(1, 1), a1 + hstep, voffA);
            PG8_WAIT_L(8); PG8_BAR; PG8_WAIT_L(0); PG8_MMA(0, 0, At, B0); PG8_BAR; PG8_SCHED;
            PG8_LDB(B1, 0, 1); PG8_STAGE(PG8_SB(0, 0), b2, voffB);
            PG8_BAR; PG8_WAIT_L(0); PG8_MMA(0, 1, At, B1); PG8_BAR;
            PG8_LDA(At, 0, 1); PG8_STAGE(PG8_SA(0, 0), a2, voffA);
            PG8_BAR; PG8_WAIT_L(0); PG8_MMA(1, 0, At, B0); PG8_BAR; PG8_SCHED;
            PG8_STAGE(PG8_SB(0, 1), b2 + hstep, voffB);
            PG8_WAIT_V(6); PG8_BAR; PG8_MMA(1, 1, At, B1); PG8_BAR;
            PG8_LDB(B0, 1, 0); PG8_SCHED; PG8_LDA(At, 1, 0); PG8_STAGE(PG8_SA(0, 1), a2 + hstep, voffA);
            PG8_WAIT_L(8); PG8_BAR; PG8_WAIT_L(0); PG8_MMA(0, 0, At, B0); PG8_BAR; PG8_SCHED;
            PG8_LDB(B1, 1, 1); PG8_STAGE(PG8_SB(1, 0), b3, voffB);
            PG8_BAR; PG8_WAIT_L(0); PG8_MMA(0, 1, At, B1); PG8_BAR;
            PG8_LDA(At, 1, 1); PG8_STAGE(PG8_SA(1, 0), a3, voffA);
            PG8_BAR; PG8_WAIT_L(0); PG8_MMA(1, 0, At, B0); PG8_BAR; PG8_SCHED;
            PG8_STAGE(PG8_SB(1, 1), b3 + hstep, voffB);
            PG8_WAIT_V(6); PG8_BAR; PG8_MMA(1, 1, At, B1); PG8_BAR;
            }
        }
        if constexpr (ALIGN_EPI) { if (wr == 0) PG8_BAR; }
        if constexpr (!Epi::AFTER_DRAIN) { E(acc, cur, wr, wc, fr, fq); S.done(cur); }
        if (!has_next) break;
#pragma unroll
        for (int a = 0; a < 2; ++a)
#pragma unroll
            for (int b = 0; b < 2; ++b)
#pragma unroll
                for (int m = 0; m < 4; ++m)
#pragma unroll
                    for (int n = 0; n < 2; ++n) acc[a][b][m][n] = (f32x4){0.f, 0.f, 0.f, 0.f};
        cur = nxt; cA = nA; cB = nB; ++ui;
        if constexpr (ALIGN_EPI) { if (wr == 1) PG8_BAR; }
    }
    PG8_WAIT_V(0);
    if constexpr (!ALIGN_EPI) { if (wr == 0) PG8_BAR; }
    PG8_BAR;
    if constexpr (Epi::AFTER_DRAIN) { E.fused(acc, cur, wr, wc, fr, fq, lds, wid, lane); S.done(cur); }
#undef PG8_SA
#undef PG8_SB
#undef PG8_STAGE
#undef PG8_LDA
#undef PG8_LDB
#undef PG8_MMA
#undef PG8_WAIT_V
#undef PG8_WAIT_L
#undef PG8_BAR
#undef PG8_SCHED
}
}

#define LAS __attribute__((address_space(3)))
typedef unsigned short bf16_t;
typedef short bf16x8 __attribute__((ext_vector_type(8)));
typedef short s16x4 __attribute__((ext_vector_type(4)));
typedef short v4i16_t __attribute__((ext_vector_type(4)));
typedef float f32x4 __attribute__((ext_vector_type(4)));
typedef float f32x2v __attribute__((ext_vector_type(2)));
typedef float f32x16 __attribute__((ext_vector_type(16)));
typedef unsigned u32x4 __attribute__((ext_vector_type(4)));
typedef unsigned u32x2 __attribute__((ext_vector_type(2)));
typedef __bf16 bf2_t __attribute__((ext_vector_type(2)));

constexpr int NTOK = 32768, DM = 1024, SEQ = 4096, NA = 2304, NB = 5632;
constexpr float EPS = 1e-6f, LOG2E = 1.4426950408889634f, QSCALE = 0.125f * 1.4426950408889634f;
constexpr size_t MiB = 1u << 20;
constexpr size_t WS_WINA = 0, WS_WINB = 10 * MiB, WS_WOUT = 32 * MiB, WS_XB = 40 * MiB, WS_ROWSQ = 104 * MiB, WS_ROPE = 105 * MiB,
                 WS_Q = 106 * MiB, WS_K = 298 * MiB, WS_V = 346 * MiB, WS_G = 394 * MiB, WS_LO8 = 458 * MiB, WS_END = 490 * MiB;
constexpr size_t WS_CTL = 105 * MiB + 512 * 1024, CTL_BYTES = 16384;
constexpr int MISC_OFF = 155584;
constexpr int LDS_BYTES = 155648;

struct Params {
    const float* x; const float* norm_a; const float* w_in_a; const float* q_gain_a; const float* k_gain_a; const float* sinks_a; const float* w_out_a;
    const float* norm_b; const float* w_in_b; const float* q_gain_b; const float* k_gain_b; const float* w_out_b;
    float* out; unsigned char* ws;
};

__device__ __forceinline__ unsigned pkbf(float lo, float hi) { f32x2v v = {lo, hi}; return __builtin_bit_cast(unsigned, __builtin_convertvector(v, bf2_t)); }
__device__ __forceinline__ float bflo(unsigned w) { return __uint_as_float(w << 16); }
__device__ __forceinline__ float bfhi(unsigned w) { return __uint_as_float(w & 0xffff0000u); }


__device__ __forceinline__ float sum_fq(float x) {
    auto a = __builtin_amdgcn_permlane16_swap(__float_as_uint(x), __float_as_uint(x), false, false);
    const float y = __uint_as_float(a[0]) + __uint_as_float(a[1]);
    auto b = __builtin_amdgcn_permlane32_swap(__float_as_uint(y), __float_as_uint(y), false, false);
    return __uint_as_float(b[0]) + __uint_as_float(b[1]);
}
struct EpiIn {
    static constexpr bool PERM = true, AFTER_DRAIN = false;
    int mixer; const float* rowsq; const float* qg; const float* kg; const float* rope; bf16_t* Q; bf16_t* Kb; bf16_t* Vb; bf16_t* G;
    __device__ __forceinline__ void operator()(const pg8::f32x4 (&acc)[2][2][4][2], const pg8::Unit& u, int wr, int wc, int fr, int fq) const {
        const int L = 256 * u.pn + 64 * wc;
        int type, head, ld; bf16_t* dst; const float* gain = nullptr;
        if (mixer == 0) {
            if (L < 1024) { type = 0; head = L >> 6; dst = Q; ld = 1024; gain = qg; }
            else if (L < 1152) { type = 1; head = (L - 1024) >> 6; dst = Kb; ld = 128; gain = kg; }
            else if (L < 1280) { type = 2; head = (L - 1152) >> 6; dst = Vb; ld = 128; }
            else { type = 3; head = (L - 1280) >> 6; dst = G; ld = 1024; }
        } else {
            if (L < 4608) { const int g = L / 1536, l = L - g * 1536;
                if (l < 1024) { type = 0; head = l >> 6; dst = Q + (size_t)g * NTOK * 1024; ld = 1024; gain = qg + 64 * g; }
                else if (l < 1280) { type = 1; head = (l - 1024) >> 6; dst = Kb + (size_t)g * NTOK * 256; ld = 256; gain = kg + 64 * g; }
                else { type = 2; head = (l - 1280) >> 6; dst = Vb + (size_t)g * NTOK * 256; ld = 256; } }
            else { type = 3; head = (L - 4608) >> 6; dst = G; ld = 1024; }
        }
        dst += head * 64 + 8 * fq;
        float rstd[2][4];
#pragma unroll
        for (int ai = 0; ai < 2; ++ai)
#pragma unroll
            for (int m = 0; m < 4; ++m) rstd[ai][m] = rowsq[u.pm * 256 + ai * 128 + wr * 64 + m * 16 + fr];
#pragma unroll
        for (int ai = 0; ai < 2; ++ai)
#pragma unroll
            for (int m = 0; m < 4; ++m) rstd[ai][m] = __builtin_amdgcn_rsqf(rstd[ai][m] * (1.0f / 1024.0f) + EPS);
        if (type <= 1) rows<0>(acc, u, wr, fr, fq, rstd, dst, ld, gain, type == 0 ? QSCALE : 1.0f);
        else if (type == 2) rows<2>(acc, u, wr, fr, fq, rstd, dst, ld, nullptr, 1.0f);
        else rows<3>(acc, u, wr, fr, fq, rstd, dst, ld, nullptr, 1.0f);
    }
    template <int TYPE  >
    __device__ __forceinline__ void rows(const pg8::f32x4 (&acc)[2][2][4][2], const pg8::Unit& u, int wr, int fr, int fq, const float (&rstd)[2][4], bf16_t* dst, int ld, const float* gain, float qs) const {
        float gn[2][2][4];
        if (TYPE == 0) {
#pragma unroll
            for (int bj = 0; bj < 2; ++bj)
#pragma unroll
                for (int n = 0; n < 2; ++n) { const int d0 = (bj == 0 && fq < 2) ? 4 * fq + 8 * n : 32 * bj + 8 * fq + 4 * n;
                    const f32x4 g4 = *(const f32x4*)(gain + d0);
#pragma unroll
                    for (int e = 0; e < 4; ++e) gn[bj][n][e] = g4[e] * qs; }
        }
#pragma unroll
        for (int ai = 0; ai < 2; ++ai)
#pragma unroll
            for (int m = 0; m < 4; ++m) {
                const int row = u.pm * 256 + ai * 128 + wr * 64 + m * 16 + fr;
                float v[2][2][4];
                if (TYPE == 0) {
                    float ss = 0.f;
#pragma unroll
                    for (int bj = 0; bj < 2; ++bj)
#pragma unroll
                        for (int n = 0; n < 2; ++n)
#pragma unroll
                            for (int e = 0; e < 4; ++e) ss += acc[ai][bj][m][n][e] * acc[ai][bj][m][n][e];
                    ss = sum_fq(ss);
                    const float r1 = rstd[ai][m], sc = r1 * __builtin_amdgcn_rsqf(r1 * r1 * ss * (1.0f / 64.0f) + EPS);
#pragma unroll
                    for (int bj = 0; bj < 2; ++bj)
#pragma unroll
                        for (int n = 0; n < 2; ++n)
#pragma unroll
                            for (int e = 0; e < 4; ++e) v[bj][n][e] = acc[ai][bj][m][n][e] * sc * gn[bj][n][e];
                    const float* rp = rope + (size_t)(row & (SEQ - 1)) * 16 + 4 * (fq & 1);
                    const f32x4 cs = *(const f32x4*)rp, sn = *(const f32x4*)(rp + 8);
#pragma unroll
                    for (int e = 0; e < 4; ++e) {
                        const float t1 = v[0][0][e], t2 = v[0][1][e];
                        const float o1 = t1 * cs[e] - t2 * sn[e], o2 = t2 * cs[e] + t1 * sn[e];
                        v[0][0][e] = fq < 2 ? o1 : t1; v[0][1][e] = fq < 2 ? o2 : t2;
                    }
                } else {
#pragma unroll
                    for (int bj = 0; bj < 2; ++bj)
#pragma unroll
                        for (int n = 0; n < 2; ++n)
#pragma unroll
                            for (int e = 0; e < 4; ++e) { const float z = acc[ai][bj][m][n][e] * rstd[ai][m]; v[bj][n][e] = TYPE == 3 ? z * __builtin_amdgcn_rcpf(1.0f + __expf(-z)) : z; }
                }
                bf16_t* rowp = dst + (size_t)row * ld;
#pragma unroll
                for (int bj = 0; bj < 2; ++bj) {
                    u32x4 w; w.x = pkbf(v[bj][0][0], v[bj][0][1]); w.y = pkbf(v[bj][0][2], v[bj][0][3]); w.z = pkbf(v[bj][1][0], v[bj][1][1]); w.w = pkbf(v[bj][1][2], v[bj][1][3]);
                    *(u32x4*)(rowp + 32 * bj) = w;
                }
            }
    }
};

struct EpiOut {
    static constexpr bool PERM = true, AFTER_DRAIN = false;
    const float* xin32; bf16_t* xb; unsigned char* lo8; float* out32; float* rowsq_next;
    __device__ __forceinline__ void operator()(const pg8::f32x4 (&acc)[2][2][4][2], const pg8::Unit& u, int wr, int wc, int fr, int fq) const {
        if (xin32) run<true, false>(acc, u, wr, wc, fr, fq); else if (out32) run<false, true>(acc, u, wr, wc, fr, fq); else run<false, false>(acc, u, wr, wc, fr, fq);
    }
    template <bool INF, bool OUTF>
    __device__ __forceinline__ void run(const pg8::f32x4 (&acc)[2][2][4][2], const pg8::Unit& u, int wr, int wc, int fr, int fq) const {
        const size_t off0 = (size_t)(u.pm * 256 + wr * 64 + fr) * DM + (u.pn * 256 + wc * 32 + 8 * fq);
        f32x4 xa[2][2][2]; u32x4 xh[2][2]; u32x2 xl[2][2];
#define EPO_LOAD(B, OFF) { _Pragma("unroll") for (int bj = 0; bj < 2; ++bj) { const size_t o2 = (OFF) + bj * 128; \
            if (INF) { xa[B][bj][0] = *(const f32x4*)(xin32 + o2); xa[B][bj][1] = *(const f32x4*)(xin32 + o2 + 4); } \
            else { xh[B][bj] = *(const u32x4*)(xb + o2); xl[B][bj] = *(const u32x2*)(lo8 + o2); } } }
        constexpr bool DB = !INF && !OUTF;
        if (DB) EPO_LOAD(0, off0)
#pragma unroll
        for (int blk = 0; blk < 8; ++blk) {
            const int ai = blk >> 2, m = blk & 3;
            if (!DB) EPO_LOAD(0, off0 + (size_t)(ai * 128 + m * 16) * DM)
            else if (blk + 1 < 8) { const int ai2 = (blk + 1) >> 2, m2 = (blk + 1) & 3; EPO_LOAD((blk + 1) & 1, off0 + (size_t)(ai2 * 128 + m2 * 16) * DM) }
            __builtin_amdgcn_sched_barrier(0);
            const int row = u.pm * 256 + ai * 128 + wr * 64 + m * 16 + fr;
            const size_t off = off0 + (size_t)(ai * 128 + m * 16) * DM;
            float ss = 0.f;
#pragma unroll
            for (int bj = 0; bj < 2; ++bj) {
                const size_t o2 = off + bj * 128;
                float r[8];
#pragma unroll
                for (int n = 0; n < 2; ++n) {
                    float x0, x1, x2, x3;
                    if (INF) { const f32x4 t = xa[0][bj][n]; x0 = t.x; x1 = t.y; x2 = t.z; x3 = t.w; }
                    else { const unsigned h01 = xh[DB ? (blk & 1) : 0][bj][2 * n], h23 = xh[DB ? (blk & 1) : 0][bj][2 * n + 1]; const int lw = (int)xl[DB ? (blk & 1) : 0][bj][n];
                        const f32x2v l01 = __builtin_amdgcn_cvt_pk_f32_bf8(lw, false), l23 = __builtin_amdgcn_cvt_pk_f32_bf8(lw, true);
                        x0 = bflo(h01) + l01.x * (1.0f / 1024.0f); x1 = bfhi(h01) + l01.y * (1.0f / 1024.0f); x2 = bflo(h23) + l23.x * (1.0f / 1024.0f); x3 = bfhi(h23) + l23.y * (1.0f / 1024.0f); }
                    const f32x4 a = acc[ai][bj][m][n];
                    r[4 * n] = x0 + a.x; r[4 * n + 1] = x1 + a.y; r[4 * n + 2] = x2 + a.z; r[4 * n + 3] = x3 + a.w;
                }
#pragma unroll
                for (int e = 0; e < 8; ++e) ss += r[e] * r[e];
                if (OUTF) { f32x4 w0 = {r[0], r[1], r[2], r[3]}, w1 = {r[4], r[5], r[6], r[7]}; *(f32x4*)(out32 + o2) = w0; *(f32x4*)(out32 + o2 + 4) = w1; }
                else {
                    u32x4 hw; u32x2 lw;
#pragma unroll
                    for (int k = 0; k < 4; ++k) hw[k] = pkbf(r[2 * k], r[2 * k + 1]);
#pragma unroll
                    for (int n = 0; n < 2; ++n) { int w = 0;
                        w = __builtin_amdgcn_cvt_pk_bf8_f32((r[4 * n] - bflo(hw[2 * n])) * 1024.0f, (r[4 * n + 1] - bfhi(hw[2 * n])) * 1024.0f, w, false);
                        w = __builtin_amdgcn_cvt_pk_bf8_f32((r[4 * n + 2] - bflo(hw[2 * n + 1])) * 1024.0f, (r[4 * n + 3] - bfhi(hw[2 * n + 1])) * 1024.0f, w, true);
                        lw[n] = (unsigned)w; }
                    *(u32x4*)(xb + o2) = hw; *(u32x2*)(lo8 + o2) = lw;
                }
            }
            if (!OUTF) { ss = sum_fq(ss); if (fq == 0) atomicAdd(rowsq_next + row, ss); }
            __builtin_amdgcn_sched_barrier(0);
        }
#undef EPO_LOAD
    }
};


typedef __attribute__((address_space(1))) unsigned gu32;
#define XB_TMO      128
#define XB_XCNT(j)  (256  + 64 * (j))
#define XB_XSUB(j)  (1280 + 64 * (j))
#define XB_XGEN(j)  (2304 + 64 * (j))
#define XB_TOP      3328
#define XB_TOPGEN   3392
#define XCD_BAR_WORDS 3456
#define XB_SPIN_CAP (1u << 18)

__device__ __forceinline__ unsigned xb_ld(unsigned* p)              { return __hip_atomic_load(p, __ATOMIC_RELAXED, __HIP_MEMORY_SCOPE_AGENT); }
__device__ __forceinline__ unsigned xb_add(unsigned* p, unsigned v) { return __hip_atomic_fetch_add(p, v, __ATOMIC_RELAXED, __HIP_MEMORY_SCOPE_AGENT); }
__device__ __forceinline__ unsigned xb_xcc_id() { return (unsigned)__builtin_amdgcn_s_getreg((3 << 11) | 20) & 0xFu; }
#define XB_SPIN(cond, bar) do { unsigned _sp = 0; while (cond) { __builtin_amdgcn_s_sleep(1); \
    if ((++_sp & 255u) == 0u) { if (xb_ld(&(bar)[XB_TMO])) break; if (_sp > XB_SPIN_CAP) { atomicAdd(&(bar)[XB_TMO], 1u); break; } } } } while (0)

struct XcdBarrier {
    unsigned* bar; unsigned x;
    volatile LAS unsigned* st;
};

__device__ __forceinline__ XcdBarrier xcd_barrier_post(unsigned* bar, volatile LAS unsigned* st) {
    XcdBarrier b; b.bar = bar; b.x = xb_xcc_id(); b.st = st;
    if (threadIdx.x == 0) (void)xb_add(&bar[XB_XCNT(b.x)], 1u);
    return b;
}
__device__ __forceinline__ void xcd_barrier_complete(unsigned* bar, unsigned x, unsigned& nloc, unsigned& nx) {
    const unsigned G = gridDim.x * gridDim.y * gridDim.z;
    unsigned sum, cnt, mine, sp = 0u;
    for (;;) {
        sum = 0u; cnt = 0u; mine = 0u;
#pragma unroll
        for (unsigned j = 0; j < 16; ++j) { const unsigned c = xb_ld(&bar[XB_XCNT(j)]); sum += c; cnt += (c > 0u) ? 1u : 0u; mine = (j == x) ? c : mine; }
        if (sum == G) break;
        __builtin_amdgcn_s_sleep(1);
        if ((++sp & 255u) == 0u) { if (xb_ld(&bar[XB_TMO])) break; if (sp > XB_SPIN_CAP) { atomicAdd(&bar[XB_TMO], 1u); break; } }
    }
    nloc = mine > 0u ? mine : 1u; nx = cnt > 0u ? cnt : 1u;
}

__device__ __forceinline__ void xcd_barrier(const XcdBarrier& b) {
    asm volatile("s_waitcnt vmcnt(0)" ::: "memory");
    __syncthreads();
    if (threadIdx.x == 0) {
        unsigned* bar = b.bar;
        __builtin_amdgcn_s_waitcnt(0);
        unsigned nloc = b.st[0], nx = b.st[1];
        if (nloc == 0u) { xcd_barrier_complete(bar, b.x, nloc, nx); b.st[0] = nloc; b.st[1] = nx; }
        const unsigned old = xb_add(&bar[XB_XSUB(b.x)], 1u);
        const unsigned gen = old / nloc;
        if (old + 1u == (gen + 1u) * nloc) {
            __builtin_amdgcn_fence(__ATOMIC_RELEASE, "agent");
            asm volatile("s_waitcnt vmcnt(0)" ::: "memory");
            const unsigned og = xb_add(&bar[XB_TOP], 1u);
            const unsigned tg = og / nx;
            if (og + 1u == (tg + 1u) * nx) xb_add(&bar[XB_TOPGEN], 1u);
            else XB_SPIN(xb_ld(&bar[XB_TOPGEN]) == tg, bar);
            __builtin_amdgcn_fence(__ATOMIC_ACQUIRE, "agent");
            xb_add(&bar[XB_XGEN(b.x)], 1u);
            asm volatile("s_waitcnt vmcnt(0)" ::: "memory");
        } else {
            XB_SPIN(xb_ld(&bar[XB_XGEN(b.x)]) == gen, bar);
            __builtin_amdgcn_fence(__ATOMIC_ACQUIRE, "agent");
            asm volatile("s_waitcnt vmcnt(0)" ::: "memory");
        }
    }
    __syncthreads();
}

__device__ __forceinline__ float wave_sum(float v) {
#pragma unroll
    for (int o = 1; o < 64; o <<= 1) v += __shfl_xor(v, o);
    return v;
}
__device__ __forceinline__ void p0_transpose_item(const float* W, int K, int N, bf16_t* WT, const float* gain, bool permute, LAS float* scr, int item, int lane) {
    const int nblk = N / 32, kb = item / nblk, nb = item % nblk, k0 = 64 * kb, n0 = 32 * nb;
    int prow0 = n0; bool qkperm = false;
    if (permute) { const int pn = n0 >> 8, wc = (n0 >> 6) & 3, bj = (n0 >> 5) & 1; prow0 = 256 * pn + 128 * bj + 32 * wc;
        const bool isqk = (N == NA) ? (n0 < 1152) : (n0 < 4608 && (n0 % 1536) < 1280);
        qkperm = isqk && bj == 0; }
#pragma unroll
    for (int i = 0; i < 32; ++i) { const int kk = 2 * i + (lane >> 5); const float gk = gain ? gain[k0 + kk] : 1.0f; scr[kk * 33 + (lane & 31)] = W[(size_t)(k0 + kk) * N + n0 + (lane & 31)] * gk; }
    asm volatile("s_waitcnt lgkmcnt(0)" ::: "memory");
    const int c = lane & 7;
#pragma unroll
    for (int j = 0; j < 4; ++j) { const int n = (lane >> 3) + 8 * j; const int nsrc = (qkperm && n < 16) ? 4 * (n >> 3) + 8 * ((n >> 2) & 1) + (n & 3) : n; const LAS float* s = scr + (8 * c) * 33 + nsrc;
        u32x4 o; o.x = pkbf(s[0 * 33], s[1 * 33]); o.y = pkbf(s[2 * 33], s[3 * 33]); o.z = pkbf(s[4 * 33], s[5 * 33]); o.w = pkbf(s[6 * 33], s[7 * 33]);
        *(u32x4*)(WT + (size_t)(prow0 + n) * K + k0 + 8 * c) = o; }
    asm volatile("s_waitcnt lgkmcnt(0)" ::: "memory");
}

template <int PART>
__device__ __forceinline__ void prologue(const Params& p, LAS unsigned char* lds) {
    int tid_ = threadIdx.x; asm volatile("" : "+v"(tid_));
    const int tid = tid_, lane = tid & 63, wave = __builtin_amdgcn_readfirstlane(tid >> 6);
    LAS float* scr = (LAS float*)(lds + wave * 8704);
    const int G = gridDim.x, half = (PART == 1 && G == 256) ? 128 : 0;
    if (PART == 1 && (int)blockIdx.x < half) return;
    const int gw = ((int)blockIdx.x - half) * 8 + wave, NGW = (G - half) * 8;
    bf16_t* WinA = (bf16_t*)(p.ws + WS_WINA); bf16_t* WinB = (bf16_t*)(p.ws + WS_WINB); bf16_t* Wout = (bf16_t*)(p.ws + WS_WOUT);
    constexpr int I_A = 16 * (NA / 32), I_B = 16 * (NB / 32), I_O = 16 * (DM / 32);
    constexpr int NITEMS = 2 * I_A + 2 * I_B + 4 * I_O;
    constexpr int IT_LO = 0, IT_HI = NITEMS;
    bf16_t* xb = (bf16_t*)(p.ws + WS_XB); float* rowsq = (float*)(p.ws + WS_ROWSQ);
#pragma unroll 1
    for (int step = 0; step < 2; ++step) {
    if (((step ^ wave) & 1) == 0) {
    for (int it = IT_LO + gw; it < IT_HI; it += NGW) {
        int r = it;
        if (r < 2 * I_A) { const int i = r / I_A; r -= i * I_A; p0_transpose_item(p.w_in_a + (size_t)i * DM * NA, DM, NA, WinA + (size_t)i * NA * DM, p.norm_a + i * DM, true, scr, r, lane); continue; } r -= 2 * I_A;
        if (r < 2 * I_B) { const int i = r / I_B; r -= i * I_B; p0_transpose_item(p.w_in_b + (size_t)i * DM * NB, DM, NB, WinB + (size_t)i * NB * DM, p.norm_b + i * DM, true, scr, r, lane); continue; } r -= 2 * I_B;
        { const int layer = r / I_O; r -= layer * I_O; const float* W = (layer & 1) ? p.w_out_b + (size_t)(layer >> 1) * DM * DM : p.w_out_a + (size_t)(layer >> 1) * DM * DM;
          p0_transpose_item(W, DM, DM, Wout + (size_t)layer * DM * DM, nullptr, false, scr, r, lane); }
    }
    } else {
    for (int m0 = gw; m0 < NTOK; m0 += 4 * NGW) {
        f32x4 v[4][4];
#pragma unroll
        for (int q = 0; q < 4; ++q) { const int m = m0 + q * NGW; if (m < NTOK) { const f32x4* xr = (const f32x4*)(p.x + (size_t)m * DM) + lane;
#pragma unroll
            for (int j = 0; j < 4; ++j) v[q][j] = xr[64 * j]; } }
#pragma unroll
        for (int q = 0; q < 4; ++q) { const int m = m0 + q * NGW; if (m < NTOK) { float s = 0.f;
#pragma unroll
            for (int j = 0; j < 4; ++j) s += (v[q][j].x * v[q][j].x + v[q][j].y * v[q][j].y) + (v[q][j].z * v[q][j].z + v[q][j].w * v[q][j].w);
            s = wave_sum(s);
            u32x2* o8 = (u32x2*)(xb + (size_t)m * DM) + lane;
#pragma unroll
            for (int j = 0; j < 4; ++j) { u32x2 w; w.x = pkbf(v[q][j].x, v[q][j].y); w.y = pkbf(v[q][j].z, v[q][j].w); o8[64 * j] = w; }
            if (lane == 0) rowsq[m] = s; } }
    }
    }
    }
    const int gt = blockIdx.x * 512 + tid, NGT = gridDim.x * 512;
    for (int i = gt; i < 3 * NTOK; i += NGT) rowsq[NTOK + i] = 0.f;
    float* rope = (float*)(p.ws + WS_ROPE);
    for (int i = gt; i < SEQ * 8; i += NGT) {
        const int pos = i >> 3, j = i & 7;
        const float invf = j == 0 ? 1.0f : j == 1 ? 0.1939227432012558f : j == 2 ? 0.03760603070259094f : j == 3 ? 0.007292664609849453f : j == 4 ? 0.0014142135623842478f
                         : j == 5 ? 0.00027424818836152554f : j == 6 ? 5.318296098266728e-05f : 1.0313386155758053e-05f;
        const float ang = (float)pos * invf; float sv, cv; sincosf(ang, &sv, &cv);
        rope[pos * 16 + j] = cv; rope[pos * 16 + 8 + j] = sv;
    }
}

#ifndef PF_A
#define PF_A true
#endif
#ifndef PF_B
#define PF_B false
#endif
template <int MIX> struct AC;
template <> struct AC<0> { static constexpr int REP = 8, CT = 64, NKV = 2; };
template <> struct AC<1> { static constexpr int REP = 4, CT = 128, NKV = 4; };
constexpr int LACC_OFF = 65536, KST_OFF = 67584, ST_ROWS = 320, VST_OFF = KST_OFF + ST_ROWS * 128, ATT_END = VST_OFF + ST_ROWS * 128;
constexpr int VW_ROW = 144, VW_WAVE = 16 * VW_ROW;
static_assert(ATT_END <= 155584 && 8 * (4096 + VW_WAVE) <= 2 * ST_ROWS * 128, "attention LDS map");

#define ST_SW(row) ((((row) >> 1) & 7) ^ ((((row) >> 1) & 1) << 2))
__device__ __forceinline__ s16x4 vtr(const LAS unsigned char* p) { return __builtin_bit_cast(s16x4, __builtin_amdgcn_ds_read_tr16_b64_v4i16((LAS v4i16_t*)p)); }

#define ATT_QK(SD, GETK)                                                                                                                              \
    {   _Pragma("unroll") for (int i = 0; i < 16; ++i) SD[i] = negM2;                                                                                \
        _Pragma("unroll") for (int s = 0; s < 4; ++s) SD = __builtin_amdgcn_mfma_f32_32x32x16_bf16(GETK(s), qf[s], SD, 0, 0, 0); }
#define ATT_SMPV(KT, S, KF0, QI, MD, GETV, USE_LR, MASKALL, SHORT4)                                                                                           \
    {   float p[16];                                                                                                                                  \
        if ((KT) == 4) { const int t = (QI) - 4 * h;                                                                                                  \
            _Pragma("unroll") for (int i = 0; i < 16; ++i) { const int ci = (i & 3) + 8 * (i >> 2); p[i] = ((SHORT4) && i >= 4) ? 0.f : ((ci <= t) ? __builtin_amdgcn_exp2f(S[i]) : 0.f); } } \
        else if ((MASKALL) || (KT) == 0 || (KF0) < 0) { int lo = 128 + (QI) - 32 * (KT) - (MD); lo = (lo > -(KF0) ? lo : -(KF0)) - 4 * h;             \
            _Pragma("unroll") for (int i = 0; i < 16; ++i) { const int ci = (i & 3) + 8 * (i >> 2); p[i] = (ci >= lo) ? __builtin_amdgcn_exp2f(S[i]) : 0.f; } } \
        else { _Pragma("unroll") for (int i = 0; i < 16; ++i) p[i] = __builtin_amdgcn_exp2f(S[i]); }     \
        _Pragma("unroll") for (int hf = 0; hf < (((KT) == 4 && (SHORT4)) ? 1 : 2); ++hf) {                                                              \
            u32x4 pw; pw.x = pkbf(p[8 * hf + 0], p[8 * hf + 1]); pw.y = pkbf(p[8 * hf + 2], p[8 * hf + 3]); pw.z = pkbf(p[8 * hf + 4], p[8 * hf + 5]); pw.w = pkbf(p[8 * hf + 6], p[8 * hf + 7]); \
            const bf16x8 pb = __builtin_bit_cast(bf16x8, pw);                                                                                         \
            bf16x8 v0, v1; GETV(hf, v0, v1);                                                                                                          \
            O0 = __builtin_amdgcn_mfma_f32_32x32x16_bf16(v0, pb, O0, 0, 0, 0);                                                                        \
            O1 = __builtin_amdgcn_mfma_f32_32x32x16_bf16(v1, pb, O1, 0, 0, 0);                                                                        \
            if (USE_LR) Lr = __builtin_amdgcn_mfma_f32_32x32x16_bf16(ones8, pb, Lr, 0, 0, 0);                                                         \
        }                                                                                                                                             \
        if (!(USE_LR)) { _Pragma("unroll") for (int i = 0; i < 16; ++i) lsum_v += p[i]; } }

template <int MIX, bool DRY = false>
__device__ __forceinline__ void attn_phase(LAS unsigned char* lds, const bf16_t* Qb, const bf16_t* Kb, const bf16_t* Vb, bf16_t* Gb, const float* qg, const float* kg, const float* sinks) {
    constexpr int REP = AC<MIX>::REP, CT = AC<MIX>::CT, NKV = AC<MIX>::NKV, NG = MIX ? 3 : 1, KVW = NKV * 64, NCH = SEQ / CT, NUNITS = 8 * NCH * NKV;
    constexpr int md = (MIX == 0) ? 127 : 128;
    int tid_ = threadIdx.x; asm volatile("" : "+v"(tid_));
    const int tid = tid_, lane0 = tid & 63, wave = __builtin_amdgcn_readfirstlane(tid >> 6);
    LAS unsigned char* Oacc = lds; LAS float* lacc = (LAS float*)(lds + LACC_OFF); LAS unsigned char* Kst = lds + KST_OFF; LAS unsigned char* Vst = lds + VST_OFF;
    LAS unsigned char* kwv = Kst + wave * (4096 + VW_WAVE); LAS unsigned char* vwv = kwv + 4096;
    float Mb = 0.f;
#pragma unroll
    for (int g = 0; g < NG; ++g) { float mq = fabsf(qg[g * 64 + lane0]), mk = fabsf(kg[g * 64 + lane0]);
#pragma unroll
        for (int o = 1; o < 64; o <<= 1) { mq = fmaxf(mq, __shfl_xor(mq, o)); mk = fmaxf(mk, __shfl_xor(mk, o)); }
        Mb = fmaxf(Mb, 8.0f * mq * mk); }
#define UNIT_MAP(U) ((gridDim.x == 256) ? ((((U) & 255) & 7) * 128 + ((U) >> 8) * 32 + (((U) & 255) >> 3)) : (U))
#define STAGE_LOAD(U, ST) { const int u_ = UNIT_MAP(U), st_ = (ST); const int chunk_ = u_ % NCH, kvh_ = (u_ / NCH) % NKV, b_ = u_ / (NKV * NCH); const int t0_ = chunk_ * CT; const long rowb_ = (long)b_ * SEQ; \
        const int g_ = (st_ == 0) ? 0 : 1; const bf16_t* Kg_ = Kb + (size_t)g_ * NTOK * KVW + kvh_ * 64; const bf16_t* Vg_ = Vb + (size_t)g_ * NTOK * KVW + kvh_ * 64; \
        const int nrows_ = MIX == 0 ? 192 : (st_ == 0 ? 256 : 320); int tl_ = tid; asm volatile("" : "+v"(tl_)); const int lrow_ = tl_ >> 3, lch_ = tl_ & 7; \
        _Pragma("unroll") for (int j = 0; j < NJ; ++j) { int i = lrow_ + 64 * j; i = i < nrows_ ? i : nrows_ - 1;     \
            { long tok; if (st_ == 0) tok = t0_ - 128 + i; else { const int rl = i >= 160 ? 1 : 0, ii = i - 160 * rl; tok = t0_ + (2 * (st_ - 1) + rl) - 512 + 4 * ii; } \
                kreg[j] = *(const u32x4*)(Kg_ + (rowb_ + tok) * KVW + 8 * lch_); vreg[j] = *(const u32x4*)(Vg_ + (rowb_ + tok) * KVW + 8 * lch_); } } }
#define STAGE_STORE(ST) { const int st_ = (ST); const int nrows_ = MIX == 0 ? 192 : (st_ == 0 ? 256 : 320); int tl_ = tid; asm volatile("" : "+v"(tl_)); const int lrow_ = tl_ >> 3, lch_ = tl_ & 7; \
        _Pragma("unroll") for (int j = 0; j < NJ; ++j) { const int i = lrow_ + 64 * j; \
            if (i < nrows_) { const int o = i * 128 + ((lch_ ^ ST_SW(i)) << 4); *(LAS u32x4*)(Kst + o) = kreg[j]; *(LAS u32x4*)(Vst + o) = vreg[j]; } } }
    constexpr int NJ = MIX == 0 ? 3 : 5;
    constexpr bool PF = (MIX == 0) ? PF_A : PF_B;
    u32x4 kreg[NJ], vreg[NJ];
    if ((PF || MIX == 1) && (int)blockIdx.x < NUNITS) STAGE_LOAD(blockIdx.x, 0)
    if (MIX == 1 && (int)blockIdx.x < NUNITS) STAGE_STORE(0)
    for (int unit = blockIdx.x; unit < NUNITS; unit += gridDim.x) {
        int tidu = tid; asm volatile("" : "+v"(tidu));
        const int lane = tidu & 63, r = lane & 31, h = lane >> 5;
    const bf16x8 ones8 = {0x3F80, 0x3F80, 0x3F80, 0x3F80, 0x3F80, 0x3F80, 0x3F80, 0x3F80};
    const int trq = (lane & 15) >> 2, trp = lane & 3, trg = (lane >> 4) & 1;
    int koff[4];
#pragma unroll
    for (int s = 0; s < 4; ++s) koff[s] = r * 128 + (((2 * s + h) ^ ST_SW(r)) << 4);
    const int vrl = 4 * h + trq, vrh = vrl + 8;
    const int voff0 = vrl * 128 + (((2 * trg + (trp >> 1)) ^ ST_SW(vrl)) << 4) + 8 * (trp & 1);
    const int voff1 = vrl * 128 + (((4 + 2 * trg + (trp >> 1)) ^ ST_SW(vrl)) << 4) + 8 * (trp & 1);
    const int voff0h = vrh * 128 + (((2 * trg + (trp >> 1)) ^ ST_SW(vrh)) << 4) + 8 * (trp & 1);
    const int voff1h = vrh * 128 + (((4 + 2 * trg + (trp >> 1)) ^ ST_SW(vrh)) << 4) + 8 * (trp & 1);
    const int vkey = lane >> 3, vchunk = lane & 7;
    const int tr_lo = (4 * h + trq) * VW_ROW + (16 * trg + 4 * trp) * 2, tr_hi = tr_lo + 8 * VW_ROW;
    const int lrow = tidu >> 3, lchunk = tidu & 7;

        const int um = UNIT_MAP(unit); const int chunk = um % NCH, kvh = (um / NCH) % NKV, b = um / (NKV * NCH);
        const int t0 = chunk * CT; const long rowb = (long)b * SEQ;
        constexpr int NSTAGE = MIX ? 3 : 1;
#pragma unroll 1
        for (int st = 0; st < NSTAGE; ++st) {
            const int g = (st == 0) ? 0 : 1, dil = (st == 0) ? 1 : 4;
            const bf16_t* Qg = Qb + (size_t)g * NTOK * 1024;
            const bf16_t* Kg = Kb + (size_t)g * NTOK * KVW + kvh * 64;
            const bf16_t* Vg = Vb + (size_t)g * NTOK * KVW + kvh * 64;
            const int nrows = MIX == 0 ? 192 : (st == 0 ? 256 : 320);
            const int ntask = (MIX == 0 || st == 0) ? 16 : 8;
            constexpr bool PRE0 = (MIX == 1);
            if (!PF && !(PRE0 && st == 0)) STAGE_LOAD(unit, st)
#define TASK_DECODE(T) int hr, tl, f0, tb0; { const int t_ = (T); \
                if (MIX == 0) { hr = t_ >> 1; const int sub = t_ & 1; tl = 32 * sub + r; f0 = t0 + 32 * sub; tb0 = 32 * sub; } \
                else if (st == 0) { hr = t_ >> 2; const int sub = t_ & 3; tl = 32 * sub + r; f0 = t0 + 32 * sub; tb0 = 32 * sub; } \
                else { hr = t_ >> 1; const int rl = t_ & 1; tl = 2 * (st - 1) + rl + 4 * r; f0 = t0 >> 2; tb0 = 160 * rl; } }
            bf16x8 qn[4];
            { TASK_DECODE(wave) (void)f0; (void)tb0; const bf16_t* qp_ = Qg + (rowb + t0 + tl) * 1024 + (kvh * REP + hr) * 64 + 8 * h;
#pragma unroll
              for (int s = 0; s < 4; ++s) qn[s] = *(const bf16x8*)(qp_ + 16 * s); }
            if (!(PRE0 && st == 0)) {
                __syncthreads();
                STAGE_STORE(st)
            }
            __syncthreads();
            if (PF) { if (st + 1 < NSTAGE) STAGE_LOAD(unit, st + 1)
                      else if (MIX == 0 && unit + (int)gridDim.x < NUNITS) STAGE_LOAD(unit + (int)gridDim.x, 0) }
#pragma unroll 1
            for (int task = wave; task < ntask; task += 8) {
                TASK_DECODE(task)
                const int qi = r, head = kvh * REP + hr;
                float M2 = Mb * LOG2E; if (MIX == 0) M2 = fmaxf(Mb, sinks[head]) * LOG2E;
                const float negM2 = -M2;
                bf16x8 qf[4];
#pragma unroll
                for (int s = 0; s < 4; ++s) qf[s] = qn[s];
                if (task + 8 < ntask) { const int t2_ = task + 8; int hr2, tl2;
                    if (MIX == 0) { hr2 = t2_ >> 1; tl2 = 32 * (t2_ & 1) + r; } else { hr2 = t2_ >> 2; tl2 = 32 * (t2_ & 3) + r; }
                    const bf16_t* qp_ = Qg + (rowb + t0 + tl2) * 1024 + (kvh * REP + hr2) * 64 + 8 * h;
#pragma unroll
                    for (int s = 0; s < 4; ++s) qn[s] = *(const bf16x8*)(qp_ + 16 * s); }
                f32x16 O0, O1, Lr; float lsum_v = 0.f;
#pragma unroll
                for (int i = 0; i < 16; ++i) { O0[i] = 0.f; O1[i] = 0.f; Lr[i] = 0.f; }
                const LAS unsigned char* kbs[4]; const LAS unsigned char* vbs[4];
#pragma unroll
                for (int s = 0; s < 4; ++s) kbs[s] = Kst + tb0 * 128 + koff[s];
                vbs[0] = Vst + tb0 * 128 + voff0; vbs[1] = Vst + tb0 * 128 + voff0h; vbs[2] = Vst + tb0 * 128 + voff1; vbs[3] = Vst + tb0 * 128 + voff1h;
                f32x16 S2[2];
#define GETK_S0(s) (*(const LAS bf16x8*)(kbs[s]))
                ATT_QK(S2[0], GETK_S0)
#pragma unroll
                for (int kt = 0; kt < 5; ++kt) {
                    const int kf0 = f0 - 128 + 32 * kt;
#define GETK_S(s) (*(const LAS bf16x8*)(kbs[s] + (kt + 1) * 4096))
                    if (kt < 4) ATT_QK(S2[(kt + 1) & 1], GETK_S)
#define GETV_S(hf, v0, v1) { const s16x4 a0 = vtr(vbs[0] + kt * 4096 + (hf) * 2048), a1 = vtr(vbs[1] + kt * 4096 + (hf) * 2048), b0 = vtr(vbs[2] + kt * 4096 + (hf) * 2048), b1 = vtr(vbs[3] + kt * 4096 + (hf) * 2048); \
                             v0 = __builtin_shufflevector(a0, a1, 0, 1, 2, 3, 4, 5, 6, 7); v1 = __builtin_shufflevector(b0, b1, 0, 1, 2, 3, 4, 5, 6, 7); }
                    ATT_SMPV(kt, S2[kt & 1], kf0, qi, md, GETV_S, (MIX == 1), false, false)
                }
                const float lsum = (MIX == 1) ? Lr[0] : lsum_v + __shfl_xor(lsum_v, 32);
                if (MIX == 0) {
                    if (!DRY) {
                        const float sk = sinks[head]; const float inv = __builtin_amdgcn_rcpf(lsum + __builtin_amdgcn_exp2f((sk - fmaxf(Mb, sk)) * LOG2E));
                        bf16_t* gp = Gb + (rowb + t0 + tl) * 1024 + head * 64 + 4 * h;
#pragma unroll
                        for (int gq = 0; gq < 4; ++gq) {
                            const u32x2 g0 = *(const u32x2*)(gp + 8 * gq), g1 = *(const u32x2*)(gp + 32 + 8 * gq);
                            u32x2 w0, w1;
                            w0.x = pkbf(O0[4 * gq] * inv * bflo(g0.x), O0[4 * gq + 1] * inv * bfhi(g0.x)); w0.y = pkbf(O0[4 * gq + 2] * inv * bflo(g0.y), O0[4 * gq + 3] * inv * bfhi(g0.y));
                            w1.x = pkbf(O1[4 * gq] * inv * bflo(g1.x), O1[4 * gq + 1] * inv * bfhi(g1.x)); w1.y = pkbf(O1[4 * gq + 2] * inv * bflo(g1.y), O1[4 * gq + 3] * inv * bfhi(g1.y));
                            *(u32x2*)(gp + 8 * gq) = w0; *(u32x2*)(gp + 32 + 8 * gq) = w1;
                        }
                    }
                } else {
                    const int row = hr * CT + tl, f = ((tl >> 1) ^ (tl >> 4) ^ (hr << 2)) & 15;
                    LAS unsigned char* orow = Oacc + row * 128;
#pragma unroll
                    for (int gq = 0; gq < 4; ++gq) {
                        LAS u32x2* p0 = (LAS u32x2*)(orow + (((2 * gq + h) ^ f) << 3)); LAS u32x2* p1 = (LAS u32x2*)(orow + (((8 + 2 * gq + h) ^ f) << 3));
                        float a0 = O0[4 * gq], a1 = O0[4 * gq + 1], a2 = O0[4 * gq + 2], a3 = O0[4 * gq + 3], c0 = O1[4 * gq], c1 = O1[4 * gq + 1], c2 = O1[4 * gq + 2], c3 = O1[4 * gq + 3];
                        if (st > 0) { const u32x2 x = *p0, y = *p1; a0 += bflo(x.x); a1 += bfhi(x.x); a2 += bflo(x.y); a3 += bfhi(x.y); c0 += bflo(y.x); c1 += bfhi(y.x); c2 += bflo(y.y); c3 += bfhi(y.y); }
                        u32x2 w0, w1; w0.x = pkbf(a0, a1); w0.y = pkbf(a2, a3); w1.x = pkbf(c0, c1); w1.y = pkbf(c2, c3);
                        *p0 = w0; *p1 = w1;
                    }
                    if (h == 0) { float lv = lsum; if (st > 0) lv += lacc[row]; lacc[row] = lv; }
                }
            }
        }
        if (MIX == 1) {
            __syncthreads();
            constexpr int g = 2, dil = 16;
            const bf16_t* Qg = Qb + (size_t)g * NTOK * 1024;
            const bf16_t* Kg = Kb + (size_t)g * NTOK * KVW + kvh * 64;
            const bf16_t* Vg = Vb + (size_t)g * NTOK * KVW + kvh * 64;
#pragma unroll 1
            for (int task = wave; task < 16; task += 8) {
                const int res = task, hr = r >> 3, qi = r & 7, tl = res + 16 * qi, f0 = t0 >> 4, head = kvh * REP + hr;
                const float negM2 = -Mb * LOG2E;
                const bf16_t* qptr = Qg + (rowb + t0 + tl) * 1024 + head * 64 + 8 * h;
                bf16x8 qf[4];
#pragma unroll
                for (int s = 0; s < 4; ++s) qf[s] = *(const bf16x8*)(qptr + 16 * s);
                const long kstep = (long)32 * dil * KVW, vstep8 = (long)8 * dil * KVW;
                const bf16_t* kp = Kg + (rowb + res + (long)dil * (f0 - 128 + vkey)) * KVW + 8 * vchunk;
                const bf16_t* vp = Vg + (rowb + res + (long)dil * (f0 - 128 + vkey)) * KVW + 8 * vchunk;
                f32x16 O0, O1, Lr;
#pragma unroll
                for (int i = 0; i < 16; ++i) { O0[i] = 0.f; O1[i] = 0.f; Lr[i] = 0.f; }
                float lsum_v = 0.f; (void)lsum_v;
                bf16x8 kb[3][4]; u32x4 vb[3][4];
#pragma unroll
                for (int t = 0; t < 3; ++t) {
#pragma unroll
                    for (int s = 0; s < 4; ++s) kb[t][s] = *(const bf16x8*)(kp + t * kstep + s * vstep8);
#pragma unroll
                    for (int j = 0; j < 4; ++j) vb[t][j] = *(const u32x4*)(vp + t * kstep + j * vstep8);
                }
                __builtin_amdgcn_sched_barrier(0);
#define GETK_D(s) (*(const LAS bf16x8*)(kwv + koff[s]))
#define STAGE_K_D(T) { _Pragma("unroll") for (int j = 0; j < ((T) == 4 ? 1 : 4); ++j) *(LAS bf16x8*)(kwv + (8 * j + vkey) * 128 + ((vchunk ^ ST_SW(8 * j + vkey)) << 4)) = kb[(T) % 3][j]; }
                f32x16 S2[2];
                STAGE_K_D(0) ATT_QK(S2[0], GETK_D)
#pragma unroll
                for (int kt = 0; kt < 5; ++kt) {
                    const int kf0 = f0 - 128 + 32 * kt;
                    if (kt < 4) { STAGE_K_D(kt + 1) ATT_QK(S2[(kt + 1) & 1], GETK_D) }
#define GETV_D(hf, v0, v1) { *(LAS u32x4*)(vwv + (vkey) * VW_ROW + vchunk * 16) = vb[kt % 3][2 * (hf)]; if (kt != 4) *(LAS u32x4*)(vwv + (8 + vkey) * VW_ROW + vchunk * 16) = vb[kt % 3][2 * (hf) + 1]; \
                             const s16x4 a0 = vtr(vwv + tr_lo), a1 = vtr(vwv + tr_hi), b0 = vtr(vwv + tr_lo + 64), b1 = vtr(vwv + tr_hi + 64); \
                             v0 = __builtin_shufflevector(a0, a1, 0, 1, 2, 3, 4, 5, 6, 7); v1 = __builtin_shufflevector(b0, b1, 0, 1, 2, 3, 4, 5, 6, 7); }
                    ATT_SMPV(kt, S2[kt & 1], kf0, qi, md, GETV_D, true, true, true)
                    __builtin_amdgcn_sched_barrier(0);
                    if (kt + 3 < 5) {
#pragma unroll
                        for (int s = 0; s < (kt + 3 == 4 ? 1 : 4); ++s) kb[kt % 3][s] = *(const bf16x8*)(kp + (kt + 3) * kstep + s * vstep8);
#pragma unroll
                        for (int j = 0; j < (kt + 3 == 4 ? 1 : 4); ++j) vb[kt % 3][j] = *(const u32x4*)(vp + (kt + 3) * kstep + j * vstep8);
                    }
                    __builtin_amdgcn_sched_barrier(0);
                }
                const float lsum = Lr[0];
                const int row = hr * CT + tl, f = ((tl >> 1) ^ (tl >> 4) ^ (hr << 2)) & 15;
                LAS unsigned char* orow = Oacc + row * 128;
#pragma unroll
                for (int gq = 0; gq < 4; ++gq) {
                    LAS u32x2* p0 = (LAS u32x2*)(orow + (((2 * gq + h) ^ f) << 3)); LAS u32x2* p1 = (LAS u32x2*)(orow + (((8 + 2 * gq + h) ^ f) << 3));
                    const u32x2 x = *p0, y = *p1;
                    u32x2 w0, w1; w0.x = pkbf(O0[4 * gq] + bflo(x.x), O0[4 * gq + 1] + bfhi(x.x)); w0.y = pkbf(O0[4 * gq + 2] + bflo(x.y), O0[4 * gq + 3] + bfhi(x.y));
                    w1.x = pkbf(O1[4 * gq] + bflo(y.x), O1[4 * gq + 1] + bfhi(y.x)); w1.y = pkbf(O1[4 * gq + 2] + bflo(y.y), O1[4 * gq + 3] + bfhi(y.y));
                    *p0 = w0; *p1 = w1;
                }
                if (h == 0) lacc[row] += lsum;
            }
            __syncthreads();
            const bool more = unit + (int)gridDim.x < NUNITS;
            STAGE_LOAD(more ? unit + (int)gridDim.x : unit, 0)
#pragma unroll 4
            for (int it = 0; it < (DRY ? 0 : 8); ++it) {
                const int item = it * 512 + tidu, row = item >> 3, dg = item & 7, hr = row / CT, tl = row % CT;
                const int f = ((tl >> 1) ^ (tl >> 4) ^ (hr << 2)) & 15, head = kvh * REP + hr;
                const LAS unsigned char* orow = Oacc + row * 128;
                const u32x2 o0 = *(const LAS u32x2*)(orow + (((2 * dg) ^ f) << 3)), o1 = *(const LAS u32x2*)(orow + (((2 * dg + 1) ^ f) << 3));
                const float inv = __builtin_amdgcn_rcpf(lacc[row]);
                u32x4* gp = (u32x4*)(Gb + (rowb + t0 + tl) * 1024 + head * 64 + 8 * dg);
                const u32x4 gv = *gp;
                u32x4 w;
                w.x = pkbf(bflo(o0.x) * inv * bflo(gv.x), bfhi(o0.x) * inv * bfhi(gv.x)); w.y = pkbf(bflo(o0.y) * inv * bflo(gv.y), bfhi(o0.y) * inv * bfhi(gv.y));
                w.z = pkbf(bflo(o1.x) * inv * bflo(gv.z), bfhi(o1.x) * inv * bfhi(gv.z)); w.w = pkbf(bflo(o1.y) * inv * bflo(gv.w), bfhi(o1.y) * inv * bfhi(gv.w));
                *gp = w;
            }
            if (more) STAGE_STORE(0)
        }
    }
    __syncthreads();
}

__global__ void __launch_bounds__(512, 2) mega_fwd(Params p) {
    extern __shared__ __attribute__((aligned(16))) unsigned char lds_raw[];
    LAS unsigned char* lds = (LAS unsigned char*)lds_raw;
    cg::grid_group grid = cg::this_grid();
    bf16_t* WinA = (bf16_t*)(p.ws + WS_WINA); bf16_t* WinB = (bf16_t*)(p.ws + WS_WINB); bf16_t* Wout = (bf16_t*)(p.ws + WS_WOUT);
    bf16_t* xb = (bf16_t*)(p.ws + WS_XB); float* rowsq = (float*)(p.ws + WS_ROWSQ); const float* rope = (const float*)(p.ws + WS_ROPE);
    bf16_t* Qb = (bf16_t*)(p.ws + WS_Q); bf16_t* Kb = (bf16_t*)(p.ws + WS_K); bf16_t* Vb = (bf16_t*)(p.ws + WS_V); bf16_t* Gb = (bf16_t*)(p.ws + WS_G);
    volatile LAS unsigned* misc = (volatile LAS unsigned*)(lds + MISC_OFF);
    if (threadIdx.x < 2) misc[threadIdx.x] = 0u;
    __syncthreads();
    const XcdBarrier bar = xcd_barrier_post((unsigned*)(p.ws + WS_CTL), misc);
    prologue<0>(p, lds);
    xcd_barrier(bar);
    if (p.ws == nullptr) grid.sync();
#pragma unroll 1
    for (int layer = 0; layer < 4; ++layer) {
        const int idx = layer >> 1, mixer = layer & 1;
        {
            const int N = mixer ? NB : NA;
            pg8::Gemm g{xb, mixer ? WinB + (size_t)idx * NB * DM : WinA + (size_t)idx * NA * DM, NTOK, N, DM};
            pg8::StaticOrder S; S.init(NTOK, N, (int)gridDim.x, (int)blockIdx.x);
            EpiIn E{mixer, rowsq + (size_t)layer * NTOK, mixer ? p.q_gain_b + idx * 192 : p.q_gain_a + idx * 64, mixer ? p.k_gain_b + idx * 192 : p.k_gain_a + idx * 64, rope, Qb, Kb, Vb, Gb};
            pg8::gemm_phase<EpiIn, pg8::StaticOrder, true, true>(lds, g, S, E);
#ifdef PROBE_GEMM2
            pg8::gemm_phase<EpiIn, pg8::StaticOrder, true, true>(lds, g, S, E);
#endif
        }
        xcd_barrier(bar);
#ifdef PROBE_ATTN2
#if PROBE_ATTN2 == 2
        if (!mixer) attn_phase<0, true>(lds, Qb, Kb, Vb, Gb, p.q_gain_a + idx * 64, p.k_gain_a + idx * 64, p.sinks_a + idx * 16);
#else
        if (mixer) attn_phase<1, true>(lds, Qb, Kb, Vb, Gb, p.q_gain_b + idx * 192, p.k_gain_b + idx * 192, nullptr);
        else       attn_phase<0, true>(lds, Qb, Kb, Vb, Gb, p.q_gain_a + idx * 64, p.k_gain_a + idx * 64, p.sinks_a + idx * 16);
#endif
#endif
        if (mixer) attn_phase<1>(lds, Qb, Kb, Vb, Gb, p.q_gain_b + idx * 192, p.k_gain_b + idx * 192, nullptr);
        else       attn_phase<0>(lds, Qb, Kb, Vb, Gb, p.q_gain_a + idx * 64, p.k_gain_a + idx * 64, p.sinks_a + idx * 16);
        xcd_barrier(bar);
        {
            pg8::Gemm g{Gb, Wout + (size_t)layer * DM * DM, NTOK, DM, DM};
            pg8::StaticOrder S; S.init(NTOK, DM, (int)gridDim.x, (int)blockIdx.x);
            EpiOut E{layer == 0 ? p.x : nullptr, xb, p.ws + WS_LO8, layer == 3 ? p.out : nullptr, layer < 3 ? rowsq + (size_t)(layer + 1) * NTOK : rowsq};
            pg8::gemm_phase<EpiOut, pg8::StaticOrder, true, true>(lds, g, S, E);
        }
        if (layer < 3) xcd_barrier(bar);
    }
}

extern "C" void kernel_launch(void* const* d_in, const int* in_sizes, int n_in, void* d_out, int out_size, void* d_ws, size_t ws_size, hipStream_t stream) {
    static int grid = 0;
    if (grid == 0) {
        if (n_in != 12 || out_size != NTOK * DM || ws_size < WS_END) { fprintf(stderr, "kernel_launch: unexpected shapes (n_in %d out %d ws %zu)\n", n_in, out_size, ws_size); grid = -1; return; }
        int dev = 0, cus = 0, per_cu = 0;
        hipGetDevice(&dev); hipDeviceGetAttribute(&cus, hipDeviceAttributeMultiprocessorCount, dev);
        if (hipFuncSetAttribute((const void*)mega_fwd, hipFuncAttributeMaxDynamicSharedMemorySize, LDS_BYTES) != hipSuccess) { fprintf(stderr, "kernel_launch: hipFuncSetAttribute failed\n"); grid = -1; return; }
        if (hipOccupancyMaxActiveBlocksPerMultiprocessor(&per_cu, (const void*)mega_fwd, 512, LDS_BYTES) != hipSuccess || per_cu < 1) { fprintf(stderr, "kernel_launch: occupancy query failed (%d)\n", per_cu); (void)hipGetLastError(); per_cu = 1; }
        grid = cus * per_cu;
    }
    if (grid < 0) return;
    if (hipMemsetAsync((char*)d_ws + WS_CTL, 0, CTL_BYTES, stream) != hipSuccess) { fprintf(stderr, "kernel_launch: memset failed\n"); return; }
    Params p{};
    p.x = (const float*)d_in[0]; p.norm_a = (const float*)d_in[1]; p.w_in_a = (const float*)d_in[2]; p.q_gain_a = (const float*)d_in[3]; p.k_gain_a = (const float*)d_in[4];
    p.sinks_a = (const float*)d_in[5]; p.w_out_a = (const float*)d_in[6]; p.norm_b = (const float*)d_in[7]; p.w_in_b = (const float*)d_in[8]; p.q_gain_b = (const float*)d_in[9];
    p.k_gain_b = (const float*)d_in[10]; p.w_out_b = (const float*)d_in[11]; p.out = (float*)d_out; p.ws = (unsigned char*)d_ws;
    void* args[] = {&p};
    hipError_t e = hipLaunchCooperativeKernel((const void*)mega_fwd, dim3(grid), dim3(512), args, LDS_BYTES, stream);
    if (e != hipSuccess) fprintf(stderr, "kernel_launch: cooperative launch failed: %s (grid %d)\n", hipGetErrorString(e), grid);
}
```
